# Optimizing an MI355X kernel written in HIP

```python
import math
import jax, jax.numpy as jnp
from jax import lax
import numpy as np

D_MODEL = 4096
BATCH = 2
SEQ = 8192
DEPTH = 1

ATTN_GROUPS = ((128, 1), (512, 4), (2048, 16))
N_GROUPS = 3
ATTN_HEAD_DIM = 128
ATTN_HEADS_PER_GROUP = D_MODEL // 512
ATTN_BLOCK = 128
ATTN_QKV_WIDTH = N_GROUPS * ATTN_HEADS_PER_GROUP * ATTN_HEAD_DIM
ATTN_OUT_WIDTH = ATTN_HEADS_PER_GROUP * ATTN_HEAD_DIM
MLSTM_HEADS = 8
MLSTM_QK_DIM = D_MODEL // 16
MLSTM_V_DIM = D_MODEL // 8
MLSTM_QK_WIDTH = MLSTM_HEADS * MLSTM_QK_DIM
MLSTM_V_WIDTH = MLSTM_HEADS * MLSTM_V_DIM
MLSTM_CHUNK = 64
GATE_SOFTCAP = 15.0
D_FF = 4 * D_MODEL
RMS_EPS = 1e-6
NEG = -1e30
IN_SPLITS = (ATTN_QKV_WIDTH, ATTN_QKV_WIDTH, ATTN_QKV_WIDTH,
             MLSTM_QK_WIDTH, MLSTM_QK_WIDTH, MLSTM_V_WIDTH, MLSTM_V_WIDTH,
             MLSTM_HEADS, MLSTM_HEADS)
IN_WIDTH = sum(IN_SPLITS)

kernel_name = 'hybrid_dilated_attn_mlstm_block'


def rms_norm(x, g):
    x32 = x.astype(jnp.float32)
    y = x32 * lax.rsqrt(jnp.mean(x32 * x32, axis=-1, keepdims=True) + RMS_EPS)
    return (y * g.astype(jnp.float32)).astype(x.dtype)


def _alibi_slope_list(n):
    def pow2(m):
        start = 2.0 ** (-(2.0 ** -(math.log2(m) - 3)))
        return [start ** (i + 1) for i in range(m)]
    if math.log2(n).is_integer():
        return pow2(n)
    c = 2 ** math.floor(math.log2(n))
    return pow2(c) + _alibi_slope_list(2 * c)[0::2][: n - c]


def attn_alibi_slopes():
    s = sorted(_alibi_slope_list(N_GROUPS * ATTN_HEADS_PER_GROUP), reverse=True)
    return np.asarray(s, dtype=np.float32).reshape(N_GROUPS, ATTN_HEADS_PER_GROUP)


def dilated_window_attention(q, k, v, window, dilation, slopes):
    B, S, H, E = q.shape
    d = dilation
    w = window // d
    L = S // d
    nb = -(-L // ATTN_BLOCK)
    Lp = nb * ATTN_BLOCK

    def strided_blocks(t):
        t = t.astype(jnp.float32).reshape(B, L, d, H, E).transpose(0, 3, 2, 1, 4)
        t = jnp.pad(t, ((0, 0), (0, 0), (0, 0), (0, Lp - L), (0, 0)))
        return t.reshape(B, H, d, nb, ATTN_BLOCK, E)

    def with_prev_block(t):
        prev = jnp.pad(t, ((0, 0), (0, 0), (0, 0), (1, 0), (0, 0), (0, 0)))[:, :, :, :-1]
        return jnp.concatenate([prev, t], axis=4)

    qb = strided_blocks(q)
    kk = with_prev_block(strided_blocks(k))
    vv = with_prev_block(strided_blocks(v))
    scores = jnp.einsum('bhrnqe,bhrnke->bhrnqk', qb, kk) * (E ** -0.5)
    qi = jnp.arange(ATTN_BLOCK)
    ki = jnp.arange(2 * ATTN_BLOCK) - ATTN_BLOCK
    rel = qi[:, None] - ki[None, :]
    key_pos = (jnp.arange(nb) * ATTN_BLOCK)[:, None] + ki[None, :]
    valid = ((rel >= 0) & (rel <= w))[None] & (key_pos >= 0)[:, None, :]
    bias = -slopes[:, None, None] * (rel * d).astype(jnp.float32)[None]
    scores = scores + bias[:, None, None]
    scores = jnp.where(valid, scores, NEG)
    lse = jax.nn.logsumexp(scores, axis=-1)
    p = jnp.exp(scores - lse[..., None])
    out = jnp.einsum('bhrnqk,bhrnke->bhrnqe', p, vv)
    out = out.reshape(B, H, d, Lp, E)[:, :, :, :L].transpose(0, 3, 2, 1, 4).reshape(B, S, H, E)
    lse = lse.reshape(B, H, d, Lp)[..., :L].transpose(0, 3, 2, 1).reshape(B, S, H)
    return out, lse


def mlstm_chunkwise(q, k, v, log_i, log_f):
    B, S, H, K = q.shape
    V = v.shape[-1]
    Lc = MLSTM_CHUNK
    NC = S // Lc

    def vec_chunks(t):
        return t.astype(jnp.float32).reshape(B, NC, Lc, H, t.shape[-1]).transpose(1, 0, 3, 2, 4)

    def gate_chunks(t):
        return t.astype(jnp.float32).reshape(B, NC, Lc, H).transpose(1, 0, 3, 2)

    causal = jnp.tril(jnp.ones((Lc, Lc), dtype=bool))

    def step(carry, xs):
        C, n, m = carry
        qc, kc, vc, lic, lfc = xs
        b = jnp.cumsum(lfc, axis=-1)
        Dm = jnp.where(causal, b[..., :, None] - b[..., None, :] + lic[..., None, :], NEG)
        inter = b + m[..., None]
        m_t = jnp.maximum(inter, jnp.max(Dm, axis=-1))
        w_intra = jnp.exp(Dm - m_t[..., None])
        w_inter = jnp.exp(inter - m_t)
        A = w_intra * jnp.einsum('bhte,bhse->bhts', qc, kc)
        num = (w_inter[..., None] * jnp.einsum('bhte,bhev->bhtv', qc, C)
               + jnp.einsum('bhts,bhsv->bhtv', A, vc))
        den = w_inter * jnp.einsum('bhte,bhe->bht', qc, n) + jnp.sum(A, axis=-1)
        h = num / jnp.maximum(jnp.abs(den), jnp.exp(-m_t))[..., None]
        g = b[..., -1:] - b + lic
        m_new = jnp.maximum(b[..., -1] + m, jnp.max(g, axis=-1))
        decay = jnp.exp(b[..., -1] + m - m_new)
        wk = jnp.exp(g - m_new[..., None])
        C = decay[..., None, None] * C + jnp.einsum('bhs,bhse,bhsv->bhev', wk, kc, vc)
        n = decay[..., None] * n + jnp.einsum('bhs,bhse->bhe', wk, kc)
        return (C, n, m_new), h

    init = (jnp.zeros((B, H, K, V), jnp.float32),
            jnp.zeros((B, H, K), jnp.float32),
            jnp.full((B, H), NEG, jnp.float32))
    xs = (vec_chunks(q), vec_chunks(k), vec_chunks(v), gate_chunks(log_i), gate_chunks(log_f))
    _, hs = lax.scan(step, init, xs)
    return hs.transpose(1, 0, 3, 2, 4).reshape(B, S, H, V)


def softcap(t):
    return GATE_SOFTCAP * jnp.tanh(t / GATE_SOFTCAP)


def setup_inputs(seed: int = 0) -> dict:
    key = jax.random.key(seed)
    ks = jax.random.split(key, 16)
    nrm = jax.random.normal
    f32 = jnp.float32
    return {
        'x': nrm(ks[0], (BATCH, SEQ, D_MODEL), f32),
        'norm_mix_g': 1.0 + 0.02 * nrm(ks[1], (DEPTH, D_MODEL), f32),
        'w_in': nrm(ks[2], (DEPTH, D_MODEL, IN_WIDTH), f32) * D_MODEL ** -0.5,
        'b_igate': 0.1 * nrm(ks[3], (DEPTH, MLSTM_HEADS), f32),
        'b_fgate': jnp.linspace(3.0, 6.0, MLSTM_HEADS, dtype=f32)[None] + 0.1 * nrm(ks[4], (DEPTH, MLSTM_HEADS), f32),
        'mlstm_norm_g': 1.0 + 0.02 * nrm(ks[5], (DEPTH, MLSTM_V_WIDTH), f32),
        'w_attn_branch': nrm(ks[6], (DEPTH, ATTN_OUT_WIDTH, D_MODEL), f32) * ATTN_OUT_WIDTH ** -0.5,
        'w_mlstm_branch': nrm(ks[7], (DEPTH, MLSTM_V_WIDTH, D_MODEL), f32) * MLSTM_V_WIDTH ** -0.5,
        'w_gate': nrm(ks[8], (DEPTH, D_MODEL, 2 * D_MODEL), f32) * D_MODEL ** -0.5,
        'b_gate': 0.02 * nrm(ks[9], (DEPTH, 2 * D_MODEL), f32),
        'w_out': nrm(ks[10], (DEPTH, D_MODEL, D_MODEL), f32) * D_MODEL ** -0.5,
        'norm_mlp_g': 1.0 + 0.02 * nrm(ks[11], (DEPTH, D_MODEL), f32),
        'w_up': nrm(ks[12], (DEPTH, D_MODEL, D_FF), f32) * D_MODEL ** -0.5,
        'w_down': nrm(ks[13], (DEPTH, D_FF, D_MODEL), f32) * D_FF ** -0.5,
        'norm_final_g': 1.0 + 0.02 * nrm(ks[14], (D_MODEL,), f32),
    }


def reference(x, norm_mix_g, w_in, b_igate, b_fgate, mlstm_norm_g, w_attn_branch,
              w_mlstm_branch, w_gate, b_gate, w_out, norm_mlp_g, w_up, w_down, norm_final_g):
    B, S, _ = x.shape
    slopes = jnp.asarray(attn_alibi_slopes())
    split_at = [int(c) for c in np.cumsum(IN_SPLITS)[:-1]]
    h = x
    for layer in range(DEPTH):
        xn = rms_norm(h, norm_mix_g[layer])
        proj = xn @ w_in[layer]
        a_q, a_k, a_v, m_q, m_k, m_v, m_o, m_i, m_f = jnp.split(proj, split_at, axis=-1)

        gshape = (B, S, N_GROUPS, ATTN_HEADS_PER_GROUP, ATTN_HEAD_DIM)
        a_q, a_k, a_v = a_q.reshape(gshape), a_k.reshape(gshape), a_v.reshape(gshape)
        outs, lses = [], []
        for g, (window, dilation) in enumerate(ATTN_GROUPS):
            o_g, lse_g = dilated_window_attention(a_q[:, :, g], a_k[:, :, g], a_v[:, :, g],
                                                  window, dilation, slopes[g])
            outs.append(o_g)
            lses.append(lse_g)
        outs = jnp.stack(outs, axis=2)
        mix_w = jax.nn.softmax(jnp.stack(lses, axis=2), axis=2)
        attn = jnp.sum(mix_w[..., None] * outs, axis=2).reshape(B, S, ATTN_OUT_WIDTH).astype(x.dtype)

        q = m_q.reshape(B, S, MLSTM_HEADS, MLSTM_QK_DIM)
        k = m_k.reshape(B, S, MLSTM_HEADS, MLSTM_QK_DIM) * (MLSTM_QK_DIM ** -0.5)
        v = m_v.reshape(B, S, MLSTM_HEADS, MLSTM_V_DIM)
        log_i = softcap((m_i + b_igate[layer]).astype(jnp.float32))
        log_f = jax.nn.log_sigmoid(softcap((m_f + b_fgate[layer]).astype(jnp.float32)))
        ht = mlstm_chunkwise(q, k, v, log_i, log_f)
        ht = ht * lax.rsqrt(jnp.mean(ht * ht, axis=-1, keepdims=True) + RMS_EPS)
        ht = ht * mlstm_norm_g[layer].astype(jnp.float32).reshape(MLSTM_HEADS, MLSTM_V_DIM)
        mlstm = (ht.reshape(B, S, MLSTM_V_WIDTH) * jax.nn.sigmoid(m_o.astype(jnp.float32))).astype(x.dtype)

        br_a = attn @ w_attn_branch[layer]
        br_m = mlstm @ w_mlstm_branch[layer]
        gates = jax.nn.sigmoid(xn @ w_gate[layer] + b_gate[layer])
        g_a, g_m = jnp.split(gates, 2, axis=-1)
        h = h + (g_a * br_a + g_m * br_m) @ w_out[layer]

        hn = rms_norm(h, norm_mlp_g[layer])
        u = jnp.square(jax.nn.relu(hn @ w_up[layer]))
        h = h + u @ w_down[layer]
    return rms_norm(h, norm_final_g)
```

```cpp
#include <hip/hip_runtime.h>
#include <cstdio>
#include <cstdint>
#define PG8_NA8 32

namespace pg8 {
#define PG8_LAS __attribute__((address_space(3)))
typedef unsigned short bf16_t;
typedef short bf16x8 __attribute__((ext_vector_type(8)));
typedef int i32x4v __attribute__((ext_vector_type(4)));
typedef int i32x8v __attribute__((ext_vector_type(8)));
__device__ __forceinline__ i32x8v cat8(const bf16x8& a, const bf16x8& b) { return __builtin_shufflevector(__builtin_bit_cast(i32x4v, a), __builtin_bit_cast(i32x4v, b), 0, 1, 2, 3, 4, 5, 6, 7); }
typedef float f32x4 __attribute__((ext_vector_type(4)));
typedef unsigned u32x4 __attribute__((ext_vector_type(4)));
constexpr int BM = 256, BK = 64, HALF = 128, HTB = HALF * BK * 2  , STAGE_BYTES = 8 * HTB, NXCD = 8, WGM = 8;

__host__ __device__ __forceinline__ int lds_byte(int r, int c) { const int st = (r >> 4) * 2 + (c >> 5), rr = r & 15, cc = c & 31, ob = rr * 64 + cc * 2; return st * 1024 + (ob ^ (((ob >> 9) & 1) << 5)); }
__host__ __device__ __forceinline__ void stage_rc(int b, int& R, int& C) { const int st = b / 1024, sb = b % 1024, swz = sb ^ (((sb >> 9) & 1) << 5); R = (st >> 1) * 16 + swz / 64; C = (st & 1) * 32 + (swz % 64) / 2; }
__host__ __device__ __forceinline__ int perm32(int rho) { const int n = rho >> 4, i = rho & 15; return 8 * (i >> 2) + 4 * n + (i & 3); }

struct Unit { int pm, pn; };
struct Gemm { const bf16_t* A; const bf16_t* Bt; int M, N, K; const float* sa = nullptr; const float* sb = nullptr; };

struct StaticOrder {
    int nM, nN, nwg, G, c, wgm, skip_lo, skip_n;
    __host__ __device__ void init(int M, int N, int G_, int c_, int wgm_ = WGM, int skip_lo_ = 1 << 30, int skip_n_ = 0) { nM = M / BM; nN = N / BM; nwg = nM * nN; G = G_; c = c_; wgm = wgm_; skip_lo = skip_lo_; skip_n = skip_n_; }
    __host__ __device__ bool next(int i, Unit& u) const {
        const long L = (long)i * G + c; if (L >= nwg) return false;
        int wgid = (int)L; { const int q = nwg / NXCD, r = nwg % NXCD, xcd = wgid % NXCD, off = wgid / NXCD; wgid = (xcd < r ? xcd * (q + 1) : r * (q + 1) + (xcd - r) * q) + off; }
        const int nig = wgm * nN, gid = wgid / nig, fm = gid * wgm, gsz = (nM - fm) < wgm ? (nM - fm) : wgm;
        u.pm = fm + ((wgid % nig) % gsz); u.pn = (wgid % nig) / gsz; if (u.pn >= skip_lo) u.pn += skip_n; return true;
    }
    __device__ __forceinline__ void a_ready(const Unit&) const {}
    __device__ __forceinline__ void done(const Unit&) const {}
};
typedef __bf16 bf16x2_t __attribute__((ext_vector_type(2)));
typedef float f32x2 __attribute__((ext_vector_type(2)));
__device__ __forceinline__ unsigned cvt_pk_bf16(float lo, float hi) { const f32x2 f = {lo, hi}; return __builtin_bit_cast(unsigned, __builtin_convertvector(f, bf16x2_t)); }
__device__ __forceinline__ float bf_lo(unsigned w) { return __uint_as_float(w << 16); }
__device__ __forceinline__ float bf_hi(unsigned w) { return __uint_as_float(w & 0xffff0000u); }
__device__ __forceinline__ u32x4 pack8(const f32x4& a, const f32x4& b) { u32x4 w; w.x = cvt_pk_bf16(a[0], a[1]); w.y = cvt_pk_bf16(a[2], a[3]); w.z = cvt_pk_bf16(b[0], b[1]); w.w = cvt_pk_bf16(b[2], b[3]); return w; }
__device__ __forceinline__ float sigmoid_f(float x) { return __builtin_amdgcn_rcpf(1.0f + __expf(-x)); }
typedef unsigned u32x2 __attribute__((ext_vector_type(2)));
__device__ __forceinline__ unsigned gate_q(float g) { return (unsigned)__builtin_rintf(g * 255.0f); }
__device__ __forceinline__ u32x2 gate_pack8(const f32x4& a, const f32x4& b) {
    u32x2 w; w.x = gate_q(a[0]) | (gate_q(a[1]) << 8) | (gate_q(a[2]) << 16) | (gate_q(a[3]) << 24); w.y = gate_q(b[0]) | (gate_q(b[1]) << 8) | (gate_q(b[2]) << 16) | (gate_q(b[3]) << 24); return w;
}
__device__ __forceinline__ u32x2 gate_ld(const bf16_t* GATES, size_t row, int col) { return *(const u32x2*)((const unsigned char*)GATES + row * 8192 + col); }
__device__ __forceinline__ f32x4 gate_lo(const u32x2& g) { return (f32x4){(float)(g.x & 255u), (float)((g.x >> 8) & 255u), (float)((g.x >> 16) & 255u), (float)(g.x >> 24)} * (1.0f / 255.0f); }
__device__ __forceinline__ f32x4 gate_hi(const u32x2& g) { return (f32x4){(float)(g.y & 255u), (float)((g.y >> 8) & 255u), (float)((g.y >> 16) & 255u), (float)(g.y >> 24)} * (1.0f / 255.0f); }
__device__ __forceinline__ u32x4* t1_slot(const bf16_t* T1, const Unit& u, int ai, int m, int bj) {
    return (u32x4*)T1 + ((size_t)((u.pm * 16 + u.pn) * 16 + (ai * 4 + m) * 2 + bj) * 512 + threadIdx.x);
}
constexpr int EM = 16384;
constexpr size_t ATT_T = (size_t)EM * 3072, ATT_G = (size_t)EM * 1024;

struct EpiInProj {
    static constexpr bool PERM = true, AFTER_DRAIN = false;
    bf16_t* QKV; unsigned char* WSB; bf16_t* GATES; const float* b_gate; int pn_off; float osc;
    static constexpr size_t MQ_OFF = (size_t)730 << 20, MK_OFF = (size_t)794 << 20, MV_OFF = (size_t)858 << 20, MO_OFF = (size_t)986 << 20;
    __device__ __forceinline__ void operator()(const f32x4 (&acc)[2][2][4][2], const Unit& u, int wr, int wc, int fr, int fq) const {
        const int pn = u.pn + pn_off, row0 = u.pm * BM + wr * 64 + fr, cl = wc * 32 + 8 * fq;
        if (pn < 36) {
            const int which = pn / 12, rem = pn - which * 12, g = rem >> 2, hp = rem & 3, sh = 2 * g;
            bf16_t* base = QKV + (size_t)which * ATT_T + (size_t)g * ATT_G + cl;
#pragma unroll
            for (int ai = 0; ai < 2; ++ai)
#pragma unroll
                for (int m = 0; m < 4; ++m) {
                    const int row = row0 + ai * HALF + m * 16, b = row >> 13, t = row & 8191, r = t & ((1 << sh) - 1), j = t >> sh;
                    const size_t ro = ((size_t)(b * 8) << 13) + (size_t)r * (size_t)(8192 >> sh) + (size_t)j;
#pragma unroll
                    for (int bj = 0; bj < 2; ++bj) { const int h = hp * 2 + bj;
                        *(u32x4*)(base + ((ro + ((size_t)h << 13)) << 7)) = pack8(acc[ai][bj][m][0] * osc, acc[ai][bj][m][1] * osc); }
                }
        } else if (pn >= 68 && pn < 84) {
            unsigned char* base = WSB + MO_OFF; const int colt = (pn - 68) * 256;
#pragma unroll
            for (int ai = 0; ai < 2; ++ai)
#pragma unroll
                for (int m = 0; m < 4; ++m) { unsigned char* rowp = base + (size_t)(row0 + ai * HALF + m * 16) * 4096 + colt + cl;
#pragma unroll
                    for (int bj = 0; bj < 2; ++bj) { f32x4 v0 = acc[ai][bj][m][0], v1 = acc[ai][bj][m][1];
#pragma unroll
                        for (int q = 0; q < 4; ++q) { v0[q] = sigmoid_f(v0[q]); v1[q] = sigmoid_f(v1[q]); }
                        *(u32x2*)(rowp + bj * HALF) = gate_pack8(v0, v1); } }
        } else if (pn < 84) {
            const size_t off = pn < 44 ? MQ_OFF : pn < 52 ? MK_OFF : pn < 68 ? MV_OFF : MO_OFF;
            const int ld = pn < 52 ? 2048 : 4096, colt = (pn < 44 ? pn - 36 : pn < 52 ? pn - 44 : pn < 68 ? pn - 52 : pn - 68) * 256;
            const float sc = (pn >= 44 && pn < 52) ? 0.0625f : 1.0f;
            bf16_t* base = (bf16_t*)(WSB + off);
#pragma unroll
            for (int ai = 0; ai < 2; ++ai)
#pragma unroll
                for (int m = 0; m < 4; ++m) { bf16_t* rowp = base + (size_t)(row0 + ai * HALF + m * 16) * ld + colt + cl;
#pragma unroll
                    for (int bj = 0; bj < 2; ++bj) *(u32x4*)(rowp + bj * HALF) = pack8(acc[ai][bj][m][0] * sc, acc[ai][bj][m][1] * sc); }
        } else {
            const int colt = (pn - 84) * 256;
            f32x4 bv[2][2];
#pragma unroll
            for (int bj = 0; bj < 2; ++bj)
#pragma unroll
                for (int n = 0; n < 2; ++n) bv[bj][n] = *(const f32x4*)(b_gate + colt + bj * HALF + cl + 4 * n);
#pragma unroll
            for (int ai = 0; ai < 2; ++ai)
#pragma unroll
                for (int m = 0; m < 4; ++m) { unsigned char* rowp = (unsigned char*)GATES + (size_t)(row0 + ai * HALF + m * 16) * 8192 + colt + cl;
#pragma unroll
                    for (int bj = 0; bj < 2; ++bj) { f32x4 v0 = acc[ai][bj][m][0] + bv[bj][0], v1 = acc[ai][bj][m][1] + bv[bj][1];
#pragma unroll
                        for (int q = 0; q < 4; ++q) { v0[q] = sigmoid_f(v0[q]); v1[q] = sigmoid_f(v1[q]); }
                        *(u32x2*)(rowp + bj * HALF) = gate_pack8(v0, v1); } }
        }
    }
};
struct EpiGates8 {
    static constexpr bool PERM = true, AFTER_DRAIN = false;
    static constexpr int NA8 = PG8_NA8;
    bf16_t* GATES; const float* b_gate; bf16_t* MO; bf16_t* QKV;
    __device__ __forceinline__ void operator()(const f32x4 (&acc)[2][2][4][2], const Unit& u, int wr, int wc, int fr, int fq) const {
        const int row0 = u.pm * BM + wr * 64 + fr, cl = wc * 32 + 8 * fq;
        if (u.pn < NA8) { const EpiInProj A{QKV, nullptr, nullptr, nullptr, 0, 0.015625f}; A(acc, u, wr, wc, fr, fq); return; }
        if (u.pn < NA8 + 16) {
#pragma unroll
            for (int ai = 0; ai < 2; ++ai)
#pragma unroll
                for (int m = 0; m < 4; ++m) { bf16_t* rowp = MO + (size_t)(row0 + ai * HALF + m * 16) * 4096 + (u.pn - NA8) * 256 + cl;
#pragma unroll
                    for (int bj = 0; bj < 2; ++bj) *(u32x4*)(rowp + bj * HALF) = pack8(acc[ai][bj][m][0] * 0.015625f, acc[ai][bj][m][1] * 0.015625f); }
            return;
        }
        const int colt = (u.pn - NA8 - 16) * 256;
        f32x4 bv[2][2];
#pragma unroll
        for (int bj = 0; bj < 2; ++bj)
#pragma unroll
            for (int n = 0; n < 2; ++n) bv[bj][n] = *(const f32x4*)(b_gate + colt + bj * HALF + cl + 4 * n);
#pragma unroll
        for (int ai = 0; ai < 2; ++ai)
#pragma unroll
            for (int m = 0; m < 4; ++m) { bf16_t* rowp = GATES + (size_t)(row0 + ai * HALF + m * 16) * 8192 + colt + cl;
#pragma unroll
                for (int bj = 0; bj < 2; ++bj) { f32x4 v0 = acc[ai][bj][m][0] * 0.015625f + bv[bj][0], v1 = acc[ai][bj][m][1] * 0.015625f + bv[bj][1];
#pragma unroll
                    for (int q = 0; q < 4; ++q) { v0[q] = sigmoid_f(v0[q]); v1[q] = sigmoid_f(v1[q]); }
                    *(u32x4*)(rowp + bj * HALF) = pack8(v0, v1); } }
    }
};
struct EpiBranchA {
    static constexpr bool PERM = true, AFTER_DRAIN = false;
    bf16_t* T1;
    __device__ __forceinline__ void operator()(const f32x4 (&acc)[2][2][4][2], const Unit& u, int wr, int wc, int fr, int fq) const {
        const int row0 = u.pm * BM + wr * 64 + fr, col0 = u.pn * BM + wc * 32 + 8 * fq;
#pragma unroll
        for (int ai = 0; ai < 2; ++ai)
#pragma unroll
            for (int m = 0; m < 4; ++m) {
#pragma unroll
                for (int bj = 0; bj < 2; ++bj) *t1_slot(T1, u, ai, m, bj) = pack8(acc[ai][bj][m][0], acc[ai][bj][m][1]); }
    }
};
struct EpiBranchM {
    static constexpr bool PERM = true, AFTER_DRAIN = false;
    const bf16_t* T1; const bf16_t* GATES; bf16_t* MERGED;
    __device__ __forceinline__ void operator()(const f32x4 (&acc)[2][2][4][2], const Unit& u, int wr, int wc, int fr, int fq) const {
        const int row0 = u.pm * BM + wr * 64 + fr, col0 = u.pn * BM + wc * 32 + 8 * fq;
#pragma unroll
        for (int ai = 0; ai < 2; ++ai)
#pragma unroll
            for (int mp = 0; mp < 2; ++mp) {
                u32x2 ga[2][2], gm[2][2]; u32x4 tw[2][2];
#pragma unroll
                for (int mm = 0; mm < 2; ++mm)
#pragma unroll
                    for (int bj = 0; bj < 2; ++bj) { const size_t row = (size_t)(row0 + ai * HALF + (2 * mp + mm) * 16);
                        ga[mm][bj] = gate_ld(GATES, row, col0 + bj * HALF); gm[mm][bj] = gate_ld(GATES, row, 4096 + col0 + bj * HALF);
                        tw[mm][bj] = *t1_slot(T1, u, ai, 2 * mp + mm, bj); }
#pragma unroll
                for (int mm = 0; mm < 2; ++mm) { const int m = 2 * mp + mm; const size_t row = (size_t)(row0 + ai * HALF + m * 16);
#pragma unroll
                    for (int bj = 0; bj < 2; ++bj) { const u32x4 t = tw[mm][bj]; const f32x4 a0 = gate_lo(ga[mm][bj]), a1 = gate_hi(ga[mm][bj]), g0 = gate_lo(gm[mm][bj]), g1 = gate_hi(gm[mm][bj]);
                        f32x4 v0 = acc[ai][bj][m][0], v1 = acc[ai][bj][m][1];
                        v0 = (f32x4){bf_lo(t.x), bf_hi(t.x), bf_lo(t.y), bf_hi(t.y)} * a0 + v0 * g0;
                        v1 = (f32x4){bf_lo(t.z), bf_hi(t.z), bf_lo(t.w), bf_hi(t.w)} * a1 + v1 * g1;
                        *(u32x4*)(MERGED + row * 4096 + col0 + bj * HALF) = pack8(v0, v1); } }
            }
    }
};
struct EpiBranchM1 {
    static constexpr bool PERM = true, AFTER_DRAIN = false;
    bf16_t* T1; const bf16_t* GATES;
    __device__ __forceinline__ void operator()(const f32x4 (&acc)[2][2][4][2], const Unit& u, int wr, int wc, int fr, int fq) const {
        const int row0 = u.pm * BM + wr * 64 + fr, col0 = u.pn * BM + wc * 32 + 8 * fq;
#pragma unroll
        for (int ai = 0; ai < 2; ++ai) {
            u32x2 gm[4][2];
#pragma unroll
            for (int m = 0; m < 4; ++m)
#pragma unroll
                for (int bj = 0; bj < 2; ++bj) gm[m][bj] = gate_ld(GATES, (size_t)(row0 + ai * HALF + m * 16), 4096 + col0 + bj * HALF);
#pragma unroll
            for (int m = 0; m < 4; ++m) { const size_t row = (size_t)(row0 + ai * HALF + m * 16);
#pragma unroll
                for (int bj = 0; bj < 2; ++bj) { f32x4 v0 = acc[ai][bj][m][0] * gate_lo(gm[m][bj]), v1 = acc[ai][bj][m][1] * gate_hi(gm[m][bj]);
                    *t1_slot(T1, u, ai, m, bj) = pack8(v0, v1); } }
        }
    }
};
struct EpiBranchA2 {
    static constexpr bool PERM = true, AFTER_DRAIN = false;
    const bf16_t* T1; const bf16_t* GATES; bf16_t* MERGED;
    __device__ __forceinline__ void operator()(const f32x4 (&acc)[2][2][4][2], const Unit& u, int wr, int wc, int fr, int fq) const {
        const int row0 = u.pm * BM + wr * 64 + fr, col0 = u.pn * BM + wc * 32 + 8 * fq;
#pragma unroll
        for (int ai = 0; ai < 2; ++ai) {
            u32x2 ga[4][2]; u32x4 tw[4][2];
#pragma unroll
            for (int m = 0; m < 4; ++m)
#pragma unroll
                for (int bj = 0; bj < 2; ++bj) { const size_t row = (size_t)(row0 + ai * HALF + m * 16);
                    ga[m][bj] = gate_ld(GATES, row, col0 + bj * HALF); tw[m][bj] = *t1_slot(T1, u, ai, m, bj); }
#pragma unroll
            for (int m = 0; m < 4; ++m) { const size_t row = (size_t)(row0 + ai * HALF + m * 16);
#pragma unroll
                for (int bj = 0; bj < 2; ++bj) { const u32x4 t = tw[m][bj]; f32x4 v0 = acc[ai][bj][m][0], v1 = acc[ai][bj][m][1];
                    v0 = (f32x4){bf_lo(t.x), bf_hi(t.x), bf_lo(t.y), bf_hi(t.y)} + v0 * gate_lo(ga[m][bj]);
                    v1 = (f32x4){bf_lo(t.z), bf_hi(t.z), bf_lo(t.w), bf_hi(t.w)} + v1 * gate_hi(ga[m][bj]);
                    *(u32x4*)(MERGED + row * 4096 + col0 + bj * HALF) = pack8(v0, v1); } }
        }
    }
};
__device__ __forceinline__ void add_row_sumsq(float* ss, const float (&s)[4], int fq) {
    float r[4];
#pragma unroll
    for (int m = 0; m < 4; ++m) { float v = s[m]; v += __shfl_xor(v, 16); v += __shfl_xor(v, 32); r[m] = v; }
    const float mine = fq == 0 ? r[0] : fq == 1 ? r[1] : fq == 2 ? r[2] : r[3];
    atomicAdd(ss + (threadIdx.x & 63), mine);
}
struct EpiOutProj {
    static constexpr bool PERM = true, AFTER_DRAIN = false;
    const bf16_t* XN; const float* XR; const float* GMIX; bf16_t* H1; float* SS;
    __device__ __forceinline__ void operator()(const f32x4 (&acc)[2][2][4][2], const Unit& u, int wr, int wc, int fr, int fq) const {
        int fr_ = fr, fq_ = fq; asm volatile("" : "+v"(fr_), "+v"(fq_));
        const int row0 = u.pm * BM + wr * 64 + fr_, col0 = u.pn * BM + wc * 32 + 8 * fq_;
        f32x4 ig[2][2];
#pragma unroll
        for (int bj = 0; bj < 2; ++bj)
#pragma unroll
            for (int hh = 0; hh < 2; ++hh) { const f32x4 g = *(const f32x4*)(GMIX + col0 + bj * HALF + 4 * hh); ig[bj][hh] = (f32x4){1.0f / g[0], 1.0f / g[1], 1.0f / g[2], 1.0f / g[3]}; }
#pragma unroll
        for (int ai = 0; ai < 2; ++ai) { float s[4];
            u32x4 xw[4][2]; float xr[4];
#pragma unroll
            for (int m = 0; m < 4; ++m) { xr[m] = XR[row0 + ai * HALF + m * 16];
#pragma unroll
                for (int bj = 0; bj < 2; ++bj) xw[m][bj] = *(const u32x4*)(XN + (size_t)(row0 + ai * HALF + m * 16) * 4096 + col0 + bj * HALF); }
#pragma unroll
            for (int m = 0; m < 4; ++m) { const size_t row = (size_t)(row0 + ai * HALF + m * 16); float sq = 0.f;
#pragma unroll
                for (int bj = 0; bj < 2; ++bj) { const size_t off = row * 4096 + col0 + bj * HALF; const u32x4 t = xw[m][bj];
                    const f32x4 h0 = (f32x4){bf_lo(t.x), bf_hi(t.x), bf_lo(t.y), bf_hi(t.y)} * xr[m] * ig[bj][0] + acc[ai][bj][m][0], h1 = (f32x4){bf_lo(t.z), bf_hi(t.z), bf_lo(t.w), bf_hi(t.w)} * xr[m] * ig[bj][1] + acc[ai][bj][m][1];
                    sq += (h0[0] * h0[0] + h0[1] * h0[1]) + (h0[2] * h0[2] + h0[3] * h0[3]) + (h1[0] * h1[0] + h1[1] * h1[1]) + (h1[2] * h1[2] + h1[3] * h1[3]);
                    *(u32x4*)(H1 + off) = pack8(h0, h1); }
                s[m] = sq; }
            add_row_sumsq(SS + u.pm * BM + ai * HALF + wr * 64, s, fq); }
    }
};
struct EpiUp {
    static constexpr bool PERM = true, AFTER_DRAIN = false;
    bf16_t* U; const float* SS;
    __device__ __forceinline__ void operator()(const f32x4 (&acc)[2][2][4][2], const Unit& u, int wr, int wc, int fr, int fq) const {
        const int row0 = u.pm * BM + wr * 64 + fr, col0 = u.pn * BM + wc * 32 + 8 * fq;
        float ssv[2][4];
#pragma unroll
        for (int ai = 0; ai < 2; ++ai)
#pragma unroll
            for (int m = 0; m < 4; ++m) ssv[ai][m] = SS[row0 + ai * HALF + m * 16];
#pragma unroll
        for (int ai = 0; ai < 2; ++ai)
#pragma unroll
            for (int m = 0; m < 4; ++m) { const size_t row = (size_t)(row0 + ai * HALF + m * 16);
                const float rstd = 1.0f / sqrtf(ssv[ai][m] * (1.0f / 4096.0f) + 1e-6f);
#pragma unroll
                for (int bj = 0; bj < 2; ++bj) { f32x4 v0 = acc[ai][bj][m][0] * rstd, v1 = acc[ai][bj][m][1] * rstd;
#pragma unroll
                    for (int q = 0; q < 4; ++q) { const float a = fmaxf(v0[q], 0.f), c = fmaxf(v1[q], 0.f); v0[q] = a * a; v1[q] = c * c; }
                    *(u32x4*)(U + row * 16384 + col0 + bj * HALF) = pack8(v0, v1); } }
    }
};
struct EpiDown {
    static constexpr bool PERM = true, AFTER_DRAIN = false;
    bf16_t* H; float* SS;
    __device__ __forceinline__ void operator()(const f32x4 (&acc)[2][2][4][2], const Unit& u, int wr, int wc, int fr, int fq) const {
        const int row0 = u.pm * BM + wr * 64 + fr, col0 = u.pn * BM + wc * 32 + 8 * fq;
#pragma unroll
        for (int ai = 0; ai < 2; ++ai) { float s[4];
            u32x4 hw[4][2];
#pragma unroll
            for (int m = 0; m < 4; ++m)
#pragma unroll
                for (int bj = 0; bj < 2; ++bj) hw[m][bj] = *(const u32x4*)(H + (size_t)(row0 + ai * HALF + m * 16) * 4096 + col0 + bj * HALF);
#pragma unroll
            for (int m = 0; m < 4; ++m) { float sq = 0.f;
#pragma unroll
                for (int bj = 0; bj < 2; ++bj) { const size_t off = (size_t)(row0 + ai * HALF + m * 16) * 4096 + col0 + bj * HALF; const u32x4 t = hw[m][bj];
                    f32x4 h0 = acc[ai][bj][m][0], h1 = acc[ai][bj][m][1];
                    h0[0] += bf_lo(t.x); h0[1] += bf_hi(t.x); h0[2] += bf_lo(t.y); h0[3] += bf_hi(t.y); h1[0] += bf_lo(t.z); h1[1] += bf_hi(t.z); h1[2] += bf_lo(t.w); h1[3] += bf_hi(t.w);
                    sq += (h0[0] * h0[0] + h0[1] * h0[1]) + (h0[2] * h0[2] + h0[3] * h0[3]) + (h1[0] * h1[0] + h1[1] * h1[1]) + (h1[2] * h1[2] + h1[3] * h1[3]);
                    *(u32x4*)(H + off) = pack8(h0, h1); }
                s[m] = sq; }
            add_row_sumsq(SS + u.pm * BM + ai * HALF + wr * 64, s, fq); }
    }
};

template <class Epi, class Sched, bool ALIGN_EPI = false, bool SP2 = false, int QM = 0>
__device__ __forceinline__ void gemm_phase(PG8_LAS unsigned char* lds, const Gemm g, const Sched& S, const Epi& E) {
    constexpr bool F8 = (QM == 1), I8 = (QM == 2);
    int tid_ = threadIdx.x; asm volatile("" : "+v"(tid_));
    const int tid = tid_, wid = __builtin_amdgcn_readfirstlane(tid >> 6), lane = tid & 63, wr = wid >> 2, wc = wid & 3, fr = lane & 15, fq = lane >> 4;
    const int K = g.K, nt = K / BK;
    unsigned voffA[2], voffB[2];
#pragma unroll
    for (int i = 0; i < 2; ++i) { int R, C; stage_rc(tid * 16 + i * 8192, R, C); const int Rb = Epi::PERM ? ((R & ~31) + perm32(R & 31)) : R;
        voffA[i] = (unsigned)(R * K + C) * 2u; voffB[i] = (unsigned)(Rb * K + C) * 2u; }
    const size_t kstep = (size_t)(BK * 2);
    const size_t hstep = (size_t)HALF * K * 2;
    const size_t tstep = 2 * hstep;
    const unsigned ldsw = (unsigned)wid * 1024u;
    const int aoff = lds_byte(wr * 64 + fr, fq * 8), boff = lds_byte(wc * 32 + fr, fq * 8);
#define PG8_SA(b, h) (((b) * 2 + (h)) * HTB)
#define PG8_SB(b, h) ((4 + (b) * 2 + (h)) * HTB)
#define PG8_STAGE(bufoff, gbase, voff) do { _Pragma("unroll") for (int _i = 0; _i < 2; ++_i) \
        __builtin_amdgcn_global_load_lds((const unsigned*)((const char*)(gbase) + (voff)[_i]), (PG8_LAS unsigned*)(lds + (bufoff) + ldsw + _i * 8192), 16, 0, 0); } while (0)
#define PG8_LD16(p) (*(const PG8_LAS i32x4v*)(p))
#define PG8_LDA(dst, b, h) do { if constexpr (F8) { _Pragma("unroll") for (int m = 0; m < 4; ++m) dst##8[m] = __builtin_shufflevector(PG8_LD16(lds + PG8_SA(b, h) + aoff + m * 2048), PG8_LD16(lds + PG8_SA(b, h) + aoff + m * 2048 + 1024), 0, 1, 2, 3, 4, 5, 6, 7); } \
        else { _Pragma("unroll") for (int m = 0; m < 4; ++m) _Pragma("unroll") for (int k = 0; k < 2; ++k) dst[m][k] = *(const PG8_LAS bf16x8*)(lds + PG8_SA(b, h) + aoff + m * 2048 + k * 1024); } } while (0)
#define PG8_LDB(dst, b, h) do { if constexpr (F8) { _Pragma("unroll") for (int n = 0; n < 2; ++n) dst##8[n] = __builtin_shufflevector(PG8_LD16(lds + PG8_SB(b, h) + boff + n * 2048), PG8_LD16(lds + PG8_SB(b, h) + boff + n * 2048 + 1024), 0, 1, 2, 3, 4, 5, 6, 7); } \
        else { _Pragma("unroll") for (int n = 0; n < 2; ++n) _Pragma("unroll") for (int k = 0; k < 2; ++k) dst[n][k] = *(const PG8_LAS bf16x8*)(lds + PG8_SB(b, h) + boff + n * 2048 + k * 1024); } } while (0)
#define PG8_MMA(ai, bj, At, Bt) do { __builtin_amdgcn_s_setprio(1); _Pragma("unroll") for (int m = 0; m < 4; ++m) _Pragma("unroll") for (int n = 0; n < 2; ++n) { \
        if constexpr (F8) asm volatile("v_mfma_scale_f32_16x16x128_f8f6f4 %0, %1, %2, %0, %3, %3 op_sel_hi:[0,0,0]" : "+v"(acc[ai][bj][m][n]) : "v"(Bt##8[n]), "v"(At##8[m]), "v"(f8scale)); \
        else if constexpr (I8) { _Pragma("unroll") for (int k = 0; k < 2; ++k) acc[ai][bj][m][n] = __builtin_bit_cast(f32x4, __builtin_amdgcn_mfma_i32_16x16x64_i8(__builtin_bit_cast(i32x4v, Bt[n][k]), __builtin_bit_cast(i32x4v, At[m][k]), __builtin_bit_cast(i32x4v, acc[ai][bj][m][n]), 0, 0, 0)); } \
        else { _Pragma("unroll") for (int k = 0; k < 2; ++k) acc[ai][bj][m][n] = __builtin_amdgcn_mfma_f32_16x16x32_bf16(Bt[n][k], At[m][k], acc[ai][bj][m][n], 0, 0, 0); } } \
        __builtin_amdgcn_s_setprio(0); } while (0)
#define PG8_WAIT_V(n) asm volatile("s_waitcnt vmcnt(" #n ")" ::: "memory")
#define PG8_WAIT_L(n) asm volatile("s_waitcnt lgkmcnt(" #n ")" ::: "memory")
#define PG8_BAR __builtin_amdgcn_s_barrier()
#define PG8_SCHED __builtin_amdgcn_sched_barrier(0)
    Unit cur, nxt; int ui = 0;
    if (!S.next(0, cur)) return;
    f32x4 acc[2][2][4][2];
#pragma unroll
    for (int a = 0; a < 2; ++a)
#pragma unroll
        for (int b = 0; b < 2; ++b)
#pragma unroll
            for (int m = 0; m < 4; ++m)
#pragma unroll
                for (int n = 0; n < 2; ++n) acc[a][b][m][n] = (f32x4){0.f, 0.f, 0.f, 0.f};
    bf16x8 At[4][2], B0[2][2], B1[2][2];
    const int f8scale = 0x7f7f7f7f;
    i32x8v At8[4], B08[2], B18[2];
    const char* cA = (const char*)g.A + (size_t)cur.pm * tstep; const char* cB = (const char*)g.Bt + (size_t)cur.pn * tstep;
    S.a_ready(cur);
    if constexpr (SP2) {
        PG8_STAGE(PG8_SB(0, 0), cB, voffB); PG8_STAGE(PG8_SB(0, 1), cB + hstep, voffB); PG8_STAGE(PG8_SA(0, 0), cA, voffA); PG8_STAGE(PG8_SA(0, 1), cA + hstep, voffA);
        if (wr == 1) PG8_BAR;
        PG8_WAIT_V(2); PG8_BAR;
        PG8_STAGE(PG8_SB(1, 0), cB + kstep, voffB); PG8_STAGE(PG8_SA(1, 0), cA + kstep, voffA); PG8_STAGE(PG8_SB(1, 1), cB + hstep + kstep, voffB);
        PG8_WAIT_V(6); PG8_BAR;
    } else {
        PG8_STAGE(PG8_SB(0, 0), cB, voffB); PG8_STAGE(PG8_SA(0, 0), cA, voffA); PG8_STAGE(PG8_SB(0, 1), cB + hstep, voffB); PG8_STAGE(PG8_SA(0, 1), cA + hstep, voffA);
        if (wr == 1) PG8_BAR;
        PG8_WAIT_V(4); PG8_BAR;
        PG8_STAGE(PG8_SB(1, 0), cB + kstep, voffB); PG8_STAGE(PG8_SA(1, 0), cA + kstep, voffA); PG8_STAGE(PG8_SB(1, 1), cB + hstep + kstep, voffB);
        PG8_WAIT_V(6); PG8_BAR;
    }
    for (;;) {
        const bool has_next = S.next(ui + 1, nxt);
        const char* nA = has_next ? (const char*)g.A + (size_t)nxt.pm * tstep : cA; const char* nB = has_next ? (const char*)g.Bt + (size_t)nxt.pn * tstep : cB;
        for (int t = 0; t < nt; t += 2) {
            const bool last = (t == nt - 2);
            const char* a1 = cA + (size_t)(t + 1) * kstep;
            const char* a2 = last ? nA : cA + (size_t)(t + 2) * kstep; const char* b2 = last ? nB : cB + (size_t)(t + 2) * kstep;
            const char* a3 = a2 + kstep; const char* b3 = b2 + kstep;
            if (last && has_next) S.a_ready(nxt);
            if constexpr (SP2) {
            PG8_LDB(B0, 0, 0); PG8_LDB(B1, 0, 1); PG8_SCHED; PG8_LDA(At, 0, 0); PG8_STAGE(PG8_SA(1, 1), a1 + hstep, voffA);
            PG8_WAIT_V(8); PG8_WAIT_L(0); PG8_BAR; PG8_MMA(0, 0, At, B0); PG8_MMA(0, 1, At, B1); PG8_BAR; PG8_SCHED;
            PG8_LDA(At, 0, 1); PG8_STAGE(PG8_SB(0, 0), b2, voffB); PG8_STAGE(PG8_SB(0, 1), b2 + hstep, voffB); PG8_STAGE(PG8_SA(0, 0), a2, voffA);
            PG8_WAIT_V(8); PG8_WAIT_L(0); PG8_BAR; PG8_MMA(1, 0, At, B0); PG8_MMA(1, 1, At, B1); PG8_BAR; PG8_SCHED;
            PG8_LDB(B0, 1, 0); PG8_LDB(B1, 1, 1); PG8_SCHED; PG8_LDA(At, 1, 0); PG8_STAGE(PG8_SA(0, 1), a2 + hstep, voffA);
            PG8_WAIT_V(8); PG8_WAIT_L(0); PG8_BAR; PG8_MMA(0, 0, At, B0); PG8_MMA(0, 1, At, B1); PG8_BAR; PG8_SCHED;
            PG8_LDA(At, 1, 1); PG8_STAGE(PG8_SB(1, 0), b3, voffB); PG8_STAGE(PG8_SB(1, 1), b3 + hstep, voffB); PG8_STAGE(PG8_SA(1, 0), a3, voffA);
            PG8_WAIT_V(8); PG8_WAIT_L(0); PG8_BAR; PG8_MMA(1, 0, At, B0); PG8_MMA(1, 1, At, B1); PG8_BAR; PG8_SCHED;
            } else {
            PG8_LDB(B0, 0, 0); PG8_SCHED; PG8_LDA(At, 0, 0); PG8_STAGE(PG8_SA(1, 1), a1 + hstep, voffA);
            PG8_WAIT_L(8); PG8_BAR; PG8_WAIT_L(0); PG8_MMA(0, 0, At, B0); PG8_BAR; PG8_SCHED;
            PG8_LDB(B1, 0, 1); PG8_STAGE(PG8_SB(0, 0), b2, voffB);
            PG8_BAR; PG8_WAIT_L(0); PG8_MMA(0, 1, At, B1); PG8_BAR;
            PG8_LDA(At, 0, 1); PG8_STAGE(PG8_SA(0, 0), a2, voffA);
            PG8_BAR; PG8_WAIT_L(0); PG8_MMA(1, 0, At, B0); PG8_BAR; PG8_SCHED;
            PG8_STAGE(PG8_SB(0, 1), b2 + hstep, voffB);
            PG8_WAIT_V(6); PG8_BAR; PG8_MMA(1, 1, At, B1); PG8_BAR;
            PG8_LDB(B0, 1, 0); PG8_SCHED; PG8_LDA(At, 1, 0); PG8_STAGE(PG8_SA(0, 1), a2 + hstep, voffA);
            PG8_WAIT_L(8); PG8_BAR; PG8_WAIT_L(0); PG8_MMA(0, 0, At, B0); PG8_BAR; PG8_SCHED;
            PG8_LDB(B1, 1, 1); PG8_STAGE(PG8_SB(1, 0), b3, voffB);
            PG8_BAR; PG8_WAIT_L(0); PG8_MMA(0, 1, At, B1); PG8_BAR;
            PG8_LDA(At, 1, 1); PG8_STAGE(PG8_SA(1, 0), a3, voffA);
            PG8_BAR; PG8_WAIT_L(0); PG8_MMA(1, 0, At, B0); PG8_BAR; PG8_SCHED;
            PG8_STAGE(PG8_SB(1, 1), b3 + hstep, voffB);
            PG8_WAIT_V(6); PG8_BAR; PG8_MMA(1, 1, At, B1); PG8_BAR;
            }
        }
        int fr2 = fr, fq2 = fq;
        if constexpr (I8) {
            __builtin_amdgcn_sched_barrier(0);
            asm volatile("" : "+v"(fr2), "+v"(fq2));
#pragma unroll
            for (int ai = 0; ai < 2; ++ai) {
                float sr[4];
#pragma unroll
                for (int m = 0; m < 4; ++m) sr[m] = ((const __attribute__((address_space(1))) float*)g.sa)[cur.pm * BM + ai * HALF + wr * 64 + m * 16 + fr2];
#pragma unroll
                for (int bj = 0; bj < 2; ++bj)
#pragma unroll
                    for (int n = 0; n < 2; ++n) { const f32x4 sc = *(const __attribute__((address_space(1))) f32x4*)(g.sb + cur.pn * BM + bj * HALF + wc * 32 + 8 * fq2 + 4 * n);
#pragma unroll
                        for (int m = 0; m < 4; ++m) { const i32x4v t = __builtin_bit_cast(i32x4v, acc[ai][bj][m][n]); const float s = sr[m];
                            acc[ai][bj][m][n] = (f32x4){(float)t[0] * s * sc[0], (float)t[1] * s * sc[1], (float)t[2] * s * sc[2], (float)t[3] * s * sc[3]}; } }
            }
            __builtin_amdgcn_sched_barrier(0);
        }
        if constexpr (F8) asm volatile("s_nop 15\n\ts_nop 15" ::: "memory");
        if constexpr (ALIGN_EPI) { if (wr == 0) PG8_BAR; }
        if constexpr (!Epi::AFTER_DRAIN) { E(acc, cur, wr, wc, fr, fq); S.done(cur); }
        if (!has_next) break;
#pragma unroll
        for (int a = 0; a < 2; ++a)
#pragma unroll
            for (int b = 0; b < 2; ++b)
#pragma unroll
                for (int m = 0; m < 4; ++m)
#pragma unroll
                    for (int n = 0; n < 2; ++n) acc[a][b][m][n] = (f32x4){0.f, 0.f, 0.f, 0.f};
        cur = nxt; cA = nA; cB = nB; ++ui;
        if constexpr (ALIGN_EPI) { if (wr == 1) PG8_BAR; }
    }
    PG8_WAIT_V(0);
    if constexpr (!ALIGN_EPI) { if (wr == 0) PG8_BAR; }
    PG8_BAR;
    if constexpr (Epi::AFTER_DRAIN) { E.fused(acc, cur, wr, wc, fr, fq, lds, wid, lane); S.done(cur); }
#undef PG8_SA
#undef PG8_SB
#undef PG8_STAGE
#undef PG8_LDA
#undef PG8_LDB
#undef PG8_MMA
#undef PG8_LD16
#undef PG8_WAIT_V
#undef PG8_WAIT_L
#undef PG8_BAR
#undef PG8_SCHED
}
}
#ifndef PG8_SP2
#define PG8_SP2 true
#endif
#ifndef PG8_ALIGN
#define PG8_ALIGN true
#endif
constexpr int NWAVES = 8;
#ifndef MK_N_LAUNCHES
#define MK_N_LAUNCHES 1
#endif
constexpr int N_LAUNCHES = MK_N_LAUNCHES;
constexpr int PER_PHASE = 10;
#ifndef MK_DUP
#define MK_DUP -1
#endif
#ifndef MK_MLDUP
#define MK_MLDUP 0
#endif
#ifndef MK_NAIVE_ATTN
#define MK_NAIVE_ATTN 0
#endif
#ifndef MK_NAIVE_MLSTM
#define MK_NAIVE_MLSTM 0
#endif

constexpr int BATCH = 2, T = 8192, D = 4096, M = BATCH * T, FF = 16384;
constexpr int NCAT = 29952;
constexpr int W_IN_LD = 21520;
constexpr float RMS_EPS = 1e-6f;

constexpr size_t MiB = 1u << 20;
constexpr size_t WS_CTL = 0, CTL_ZERO_BYTES = 1 * MiB;
constexpr size_t WS_IFG = 1 * MiB, WS_LSE = 2 * MiB;
constexpr size_t WS_WATT = 8 * MiB, WS_WMLS = 16 * MiB, WS_WOUT = 48 * MiB, WS_WCAT = 80 * MiB, WS_XN = 314 * MiB;
constexpr size_t WS_QKV = 442 * MiB, WS_MQ = 730 * MiB, WS_MK = 794 * MiB, WS_MV = 858 * MiB, WS_MO = 986 * MiB;
constexpr size_t WS_AO = 80 * MiB, WS_HRAW = 176 * MiB, WS_ATT = 464 * MiB, WS_MLS = 496 * MiB, WS_WUP = 1114 * MiB, WS_WDOWN = 1242 * MiB;
constexpr size_t WS_XN8 = 1114 * MiB, WS_WG8 = WS_WCAT + (size_t)256 * (68 - PG8_NA8) * D * 2;
constexpr size_t WS_T1 = 794 * MiB, WS_MERGED = 80 * MiB, WS_HG = 848 * MiB, WS_U = 336 * MiB, WS_END = 1370 * MiB;
static_assert(WS_WCAT + (size_t)NCAT * D * 2 <= WS_XN && WS_XN + (size_t)M * D * 2 <= WS_QKV && WS_QKV + 3 * (size_t)M * 3072 * 2 <= WS_MQ, "ws map 1");
static_assert(WS_U + (size_t)M * FF * 2 <= WS_HG && WS_HG + (size_t)M * D * 2 <= WS_MO && WS_ATT >= WS_QKV && WS_ATT + (size_t)M * 1024 <= WS_MLS && WS_MLS + (size_t)M * D <= WS_MQ && WS_WDOWN + (size_t)D * FF * 2 <= WS_END && WS_MO + (size_t)M * D * 2 <= WS_WUP, "ws map 2");
constexpr int CW_TMO = 0, CW_CODE = 1, CW_BAR = 4096, CW_SS1 = 16384, CW_SA = 65536, CW_CMAX = 98304, CW_SB = 147456, CW_SAA = 196608, CW_SAM = 212992, CW_SAG = 229376, CW_XR = 245760;
static_assert(CW_XR + 16384 <= (int)(CTL_ZERO_BYTES / 4), "control region (XR)");
constexpr int CW_PAD_ = 0;
static_assert(CW_CMAX + 41984 <= CW_SB && CW_SB + 41984 <= CW_SAA && CW_SAG + 16384 <= (int)(CTL_ZERO_BYTES / 4), "control region");
constexpr int CW_UNUSED = 0;
constexpr int RING_OFF = 0, RING_BYTES = 131072;
constexpr int LDSCTL_OFF = 150528, MISC_OFF = LDSCTL_OFF + 320;
constexpr int LDS_BYTES = 155648;
static_assert(MISC_OFF + 128 <= LDS_BYTES, "LDS map");

#define GAS __attribute__((address_space(1)))
#define LAS __attribute__((address_space(3)))
typedef unsigned short bf16;
typedef unsigned v4u __attribute__((ext_vector_type(4)));
typedef unsigned v2u __attribute__((ext_vector_type(2)));
typedef float f32x4 __attribute__((ext_vector_type(4)));
typedef GAS unsigned gu32;
#define RLX_AGENT __ATOMIC_RELAXED, __HIP_MEMORY_SCOPE_AGENT
#define LDS_WAIT() asm volatile("s_waitcnt lgkmcnt(0)" ::: "memory")
#define VM_WAIT() asm volatile("s_waitcnt vmcnt(0)" ::: "memory")
__device__ __forceinline__ unsigned f2bf(float f) { unsigned u = __builtin_bit_cast(unsigned, f); return (u + 0x7fffu + ((u >> 16) & 1u)) >> 16; }
__device__ __forceinline__ unsigned pk2(float lo, float hi) { return f2bf(lo) | (f2bf(hi) << 16); }
__device__ __forceinline__ float bflo(unsigned w) { return __uint_as_float(w << 16); }
__device__ __forceinline__ float bfhi(unsigned w) { return __uint_as_float(w & 0xffff0000u); }
__device__ __forceinline__ float bf2f(bf16 h) { return __uint_as_float(((unsigned)h) << 16); }

#define XB_TMO      128
#define XB_XCNT(j)  (256  + 64 * (j))
#define XB_XSUB(j)  (1280 + 64 * (j))
#define XB_XGEN(j)  (2304 + 64 * (j))
#define XB_TOP      3328
#define XB_TOPGEN   3392
#define XCD_BAR_WORDS 3456
#define XB_SPIN_CAP (1u << 22)

__device__ __forceinline__ unsigned xb_ld(unsigned* p)              { return __hip_atomic_load(p, __ATOMIC_RELAXED, __HIP_MEMORY_SCOPE_AGENT); }
__device__ __forceinline__ unsigned xb_add(unsigned* p, unsigned v) { return __hip_atomic_fetch_add(p, v, __ATOMIC_RELAXED, __HIP_MEMORY_SCOPE_AGENT); }
__device__ __forceinline__ unsigned xb_xcc_id() { return (unsigned)__builtin_amdgcn_s_getreg((3 << 11) | 20) & 0xFu; }
#define XB_SPIN(cond, bar) do { unsigned _sp = 0; while (cond) { __builtin_amdgcn_s_sleep(1); \
    if ((++_sp & 255u) == 0u) { if (xb_ld(&(bar)[XB_TMO])) break; if (_sp > XB_SPIN_CAP) { atomicAdd(&(bar)[XB_TMO], 1u); break; } } } } while (0)

struct XcdBarrier {
    unsigned* bar; unsigned x;
    volatile LAS unsigned* st;
};

__device__ __forceinline__ XcdBarrier xcd_barrier_post(unsigned* bar, volatile LAS unsigned* st) {
    XcdBarrier b; b.bar = bar; b.x = xb_xcc_id(); b.st = st;
    if (threadIdx.x == 0) (void)xb_add(&bar[XB_XCNT(b.x)], 1u);
    return b;
}
__device__ __forceinline__ void xcd_barrier_complete(unsigned* bar, unsigned x, unsigned& nloc, unsigned& nx) {
    const unsigned G = gridDim.x * gridDim.y * gridDim.z;
    unsigned sum, cnt, mine, sp = 0u;
    for (;;) {
        sum = 0u; cnt = 0u; mine = 0u;
#pragma unroll
        for (unsigned j = 0; j < 16; ++j) { const unsigned c = xb_ld(&bar[XB_XCNT(j)]); sum += c; cnt += (c > 0u) ? 1u : 0u; mine = (j == x) ? c : mine; }
        if (sum == G) break;
        __builtin_amdgcn_s_sleep(1);
        if ((++sp & 255u) == 0u) { if (xb_ld(&bar[XB_TMO])) break; if (sp > XB_SPIN_CAP) { atomicAdd(&bar[XB_TMO], 1u); break; } }
    }
    nloc = mine > 0u ? mine : 1u; nx = cnt > 0u ? cnt : 1u;
}

__device__ __forceinline__ void xcd_barrier(const XcdBarrier& b) {
    asm volatile("s_waitcnt vmcnt(0)" ::: "memory");
    __syncthreads();
    if (threadIdx.x == 0) {
        unsigned* bar = b.bar;
        __builtin_amdgcn_s_waitcnt(0);
        unsigned nloc = b.st[0], nx = b.st[1];
        if (nloc == 0u) { xcd_barrier_complete(bar, b.x, nloc, nx); b.st[0] = nloc; b.st[1] = nx; }
        const unsigned old = xb_add(&bar[XB_XSUB(b.x)], 1u);
        const unsigned gen = old / nloc;
        if (old + 1u == (gen + 1u) * nloc) {
            __builtin_amdgcn_fence(__ATOMIC_RELEASE, "agent");
            asm volatile("s_waitcnt vmcnt(0)" ::: "memory");
            const unsigned og = xb_add(&bar[XB_TOP], 1u);
            const unsigned tg = og / nx;
            if (og + 1u == (tg + 1u) * nx) xb_add(&bar[XB_TOPGEN], 1u);
            else XB_SPIN(xb_ld(&bar[XB_TOPGEN]) == tg, bar);
            __builtin_amdgcn_fence(__ATOMIC_ACQUIRE, "agent");
            xb_add(&bar[XB_XGEN(b.x)], 1u);
            asm volatile("s_waitcnt vmcnt(0)" ::: "memory");
        } else {
            XB_SPIN(xb_ld(&bar[XB_XGEN(b.x)]) == gen, bar);
            __builtin_amdgcn_fence(__ATOMIC_ACQUIRE, "agent");
            asm volatile("s_waitcnt vmcnt(0)" ::: "memory");
        }
    }
    __syncthreads();
}

typedef float f32x4v __attribute__((ext_vector_type(4)));
typedef short bf16x8v __attribute__((ext_vector_type(8)));
typedef short s16x4v __attribute__((ext_vector_type(4)));
typedef float f32x16 __attribute__((ext_vector_type(16)));
struct Ctx {
    LAS unsigned char* lds; int tid, lane, wave, G, bx;
};
__device__ __forceinline__ float wave_sum(float v) {
#pragma unroll
    for (int o = 1; o < 64; o <<= 1) v += __shfl_xor(v, o);
    return v;
}
__device__ __forceinline__ float wave_max(float v) {
#pragma unroll
    for (int o = 1; o < 64; o <<= 1) v = fmaxf(v, __shfl_xor(v, o));
    return v;
}
template <int F8OUT = 0>
__device__ __forceinline__ void p0_transpose_item(const float* W, int K, int ld, int c0, int nblk, int ncols, bf16* WT, int row_off, LAS float* scr, int item, int lane, const float* kscale = nullptr, const unsigned* cmax = nullptr, float* sb_out = nullptr) {
    const int kb = item / nblk, nb = item % nblk, k0 = 64 * kb, n0 = 32 * nb;
    if ((lane & 31) < ncols) {
#pragma unroll 8
        for (int i = 0; i < 32; ++i) { const int kk = 2 * i + (lane >> 5); scr[kk * 33 + (lane & 31)] = W[(size_t)(k0 + kk) * ld + c0 + n0 + (lane & 31)]; }
    }
    LDS_WAIT(); asm volatile("" ::: "memory");
    const int c = lane & 7;
    f32x4 ks0 = {1.f, 1.f, 1.f, 1.f}, ks1 = ks0;
    if (kscale) { ks0 = *(const GAS f32x4*)(kscale + k0 + 8 * c); ks1 = *(const GAS f32x4*)(kscale + k0 + 8 * c + 4); }
#pragma unroll
    for (int j = 0; j < 4; ++j) { const int n = (lane >> 3) + 8 * j; const LAS float* s = scr + (8 * c) * 33 + n;
        if (F8OUT == 2) { if (n < ncols) { const float cm = __uint_as_float(cmax[row_off + n0 + n]), qs = cm > 0.f ? 127.0f / cm : 0.f;
            if (kb == 0 && c == 0) sb_out[row_off + n0 + n] = cm * (1.0f / 127.0f);
            unsigned lo = 0, hi = 0;
#pragma unroll
            for (int e = 0; e < 4; ++e) { lo |= ((unsigned)(int)__builtin_rintf(fminf(fmaxf(s[e * 33] * qs, -127.f), 127.f)) & 255u) << (8 * e); hi |= ((unsigned)(int)__builtin_rintf(fminf(fmaxf(s[(4 + e) * 33] * qs, -127.f), 127.f)) & 255u) << (8 * e); }
            *(GAS v2u*)((GAS unsigned char*)WT + (size_t)(row_off + n0 + n) * K + k0 + 8 * c) = (v2u){lo, hi}; } }
        else if (F8OUT == 1) { if (n < ncols) { int lo = 0, hi = 0;
            lo = __builtin_amdgcn_cvt_pk_fp8_f32(s[0 * 33] * 64.f, s[1 * 33] * 64.f, lo, false); lo = __builtin_amdgcn_cvt_pk_fp8_f32(s[2 * 33] * 64.f, s[3 * 33] * 64.f, lo, true);
            hi = __builtin_amdgcn_cvt_pk_fp8_f32(s[4 * 33] * 64.f, s[5 * 33] * 64.f, hi, false); hi = __builtin_amdgcn_cvt_pk_fp8_f32(s[6 * 33] * 64.f, s[7 * 33] * 64.f, hi, true);
            *(GAS v2u*)((GAS unsigned char*)WT + (size_t)(row_off + n0 + n) * K + k0 + 8 * c) = (v2u){(unsigned)lo, (unsigned)hi}; } }
        else if (n < ncols) {
            v4u o; o.x = pk2(s[0 * 33] * ks0.x, s[1 * 33] * ks0.y); o.y = pk2(s[2 * 33] * ks0.z, s[3 * 33] * ks0.w); o.z = pk2(s[4 * 33] * ks1.x, s[5 * 33] * ks1.y); o.w = pk2(s[6 * 33] * ks1.z, s[7 * 33] * ks1.w);
            *(GAS v4u*)(WT + (size_t)(row_off + n0 + n) * K + k0 + 8 * c) = o; } }
    LDS_WAIT(); asm volatile("" ::: "memory");
}
__device__ __forceinline__ void rms_row_to_bf16(const float* xrow, const float* g, bf16* orow, int lane, unsigned char* o8row = nullptr, float* sa_out = nullptr, float* inv_rstd = nullptr) {
    const GAS f32x4* xr = (const GAS f32x4*)xrow + lane; const GAS f32x4* gr = (const GAS f32x4*)g + lane;
    f32x4 v[16]; float s = 0.f;
#pragma unroll
    for (int j = 0; j < 16; ++j) { v[j] = xr[64 * j]; s += (v[j].x * v[j].x + v[j].y * v[j].y) + (v[j].z * v[j].z + v[j].w * v[j].w); }
    const float rt = sqrtf(wave_sum(s) * (1.f / D) + RMS_EPS), rstd = 1.f / rt;
    if (inv_rstd && lane == 0) *inv_rstd = rt;
    GAS v2u* o8 = (GAS v2u*)orow + lane;
    float ymax = 0.f;
#pragma unroll
    for (int j = 0; j < 16; ++j) { const f32x4 gg = gr[64 * j]; v[j].x *= rstd * gg.x; v[j].y *= rstd * gg.y; v[j].z *= rstd * gg.z; v[j].w *= rstd * gg.w;
        v2u w; w.x = pk2(v[j].x, v[j].y); w.y = pk2(v[j].z, v[j].w); o8[64 * j] = w;
        ymax = fmaxf(ymax, fmaxf(fmaxf(fabsf(v[j].x), fabsf(v[j].y)), fmaxf(fabsf(v[j].z), fabsf(v[j].w)))); }
    if (o8row) { ymax = wave_max(ymax); const float qs = ymax > 0.f ? 127.0f / ymax : 0.f;
        if (lane == 0) *sa_out = ymax * (1.0f / 127.0f);
#pragma unroll
        for (int j = 0; j < 16; ++j) { const unsigned q = ((unsigned)(int)__builtin_rintf(fminf(fmaxf(v[j].x * qs, -127.f), 127.f)) & 255u) | (((unsigned)(int)__builtin_rintf(fminf(fmaxf(v[j].y * qs, -127.f), 127.f)) & 255u) << 8) | (((unsigned)(int)__builtin_rintf(fminf(fmaxf(v[j].z * qs, -127.f), 127.f)) & 255u) << 16) | (((unsigned)(int)__builtin_rintf(fminf(fmaxf(v[j].w * qs, -127.f), 127.f)) & 255u) << 24);
            ((GAS unsigned*)o8row)[lane + 64 * j] = q; } }
}
struct P0Args { const float *x, *g_mix, *w_in, *w_attn, *w_mlstm, *w_gate, *w_out; bf16 *WCAT, *WATT, *WMLS, *WOUT, *XN; float* SS; unsigned char *XNQ, *WQ; float* SA; unsigned* CMAX; float* SB; float* XR; };
__device__ __forceinline__ void p0_pass_a(const Ctx& F, const P0Args& A) {
    const int gw = F.bx * NWAVES + F.wave, NGW = F.G * NWAVES, lane = F.lane;
    for (int it = gw; it < 116 * 16 + 64 + 256 + 256; it += NGW) {
        const float* W; int ld, c0, k0, co;
        if (it < 116 * 16) { const int cc = it % 116, kc = it / 116; W = cc < 84 ? A.w_in : A.w_gate; ld = cc < 84 ? W_IN_LD : 8192; c0 = cc < 84 ? 256 * cc : 256 * (cc - 84); k0 = 256 * kc; co = 256 * cc; }
        else if (it < 116 * 16 + 64) { const int r = it - 116 * 16; W = A.w_attn; ld = D; c0 = 256 * (r & 15); k0 = 256 * (r >> 4); co = 29696 + c0; }
        else if (it < 116 * 16 + 64 + 256) { const int r = it - 116 * 16 - 64; W = A.w_mlstm; ld = D; c0 = 256 * (r & 15); k0 = 256 * (r >> 4); co = 33792 + c0; }
        else { const int r = it - 116 * 16 - 64 - 256; W = A.w_out; ld = D; c0 = 256 * (r & 15); k0 = 256 * (r >> 4); co = 37888 + c0; }
        const GAS f32x4* p = (const GAS f32x4*)(W + (size_t)k0 * ld + c0) + lane;
        f32x4 mx = {0.f, 0.f, 0.f, 0.f};
#pragma unroll 16
        for (int k = 0; k < 256; ++k) { const f32x4 v = *(const GAS f32x4*)((const GAS float*)p + (size_t)k * ld);
            mx.x = fmaxf(mx.x, fabsf(v.x)); mx.y = fmaxf(mx.y, fabsf(v.y)); mx.z = fmaxf(mx.z, fabsf(v.z)); mx.w = fmaxf(mx.w, fabsf(v.w)); }
        unsigned* cm = A.CMAX + co + 4 * lane;
        atomicMax(cm + 0, __float_as_uint(mx.x)); atomicMax(cm + 1, __float_as_uint(mx.y)); atomicMax(cm + 2, __float_as_uint(mx.z)); atomicMax(cm + 3, __float_as_uint(mx.w));
    }
    { GAS v4u* z = (GAS v4u*)(A.WCAT + (size_t)29712 * D); const int gt = F.bx * (NWAVES * 64) + F.tid, NT = F.G * NWAVES * 64;
      for (int i = gt; i < 240 * D / 8; i += NT) z[i] = (v4u){0u, 0u, 0u, 0u}; }
    for (int m = gw; m < M; m += NGW) rms_row_to_bf16(A.x + (size_t)m * D, A.g_mix, A.XN + (size_t)m * D, lane, A.XNQ + (size_t)m * D, A.SA + m, A.XR + m);
    { const int gt = F.bx * (NWAVES * 64) + F.tid, NT = F.G * NWAVES * 64; for (int i = gt; i < 2 * M; i += NT) A.SS[i] = 0.f; }
}
__device__ __forceinline__ void p0_prologue(const Ctx& F, const P0Args& A) {
    LAS float* scr = (LAS float*)(F.lds + RING_OFF + F.wave * 16384);
    const int gw = F.bx * NWAVES + F.wave, NGW = F.G * NWAVES;
    constexpr int I_IN = 64 * 672, I_GATE = 64 * 256, I_IF = 64, I_ATT = 16 * 128, I_MLS = 64 * 128, I_OUT = 64 * 128, I_MQK = 64 * 128;
    constexpr int NITEMS = I_IN + I_GATE + I_IF + I_ATT + I_MLS + I_OUT + I_MQK;
    for (int it = gw; it < NITEMS; it += NGW) {
        int r = it;
        if (r < I_MQK) { p0_transpose_item(A.w_in, D, W_IN_LD, 9216, 128, 32, A.WCAT + (size_t)14848 * D, 0, scr, r, F.lane); continue; } r -= I_MQK;
        if (r < I_IN) { p0_transpose_item<2>(A.w_in, D, W_IN_LD, 0, 672, 32, (bf16*)A.WQ, 0, scr, r, F.lane, nullptr, A.CMAX, A.SB); continue; } r -= I_IN;
        if (r < I_GATE) { p0_transpose_item<2>(A.w_gate, D, 8192, 0, 256, 32, (bf16*)A.WQ, 21504, scr, r, F.lane, nullptr, A.CMAX, A.SB); continue; } r -= I_GATE;
        if (r < I_IF) { p0_transpose_item(A.w_in, D, W_IN_LD, 21504, 1, 16, A.WCAT, 29696, scr, r, F.lane); continue; } r -= I_IF;
        if (r < I_ATT) { p0_transpose_item<2>(A.w_attn, 1024, D, 0, 128, 32, A.WATT, 0, scr, r, F.lane, nullptr, A.CMAX + 29696, A.SB + 29696); continue; } r -= I_ATT;
        if (r < I_MLS) { p0_transpose_item<2>(A.w_mlstm, D, D, 0, 128, 32, A.WMLS, 0, scr, r, F.lane, nullptr, A.CMAX + 33792, A.SB + 33792); continue; } r -= I_MLS;
        p0_transpose_item<2>(A.w_out, D, D, 0, 128, 32, A.WOUT, 0, scr, r, F.lane, nullptr, A.CMAX + 37888, A.SB + 37888);
    }
}
__device__ __forceinline__ void p1_if_gates(const Ctx& F, const bf16* XN, const bf16* WIF, float* IFG) {
    const int gw = F.wave * F.G + F.bx, NGW = F.G * NWAVES, fr = F.lane & 15, fq = F.lane >> 4;
    for (int task = gw; task < M / 16; task += NGW) {
        const bf16* ap = XN + (size_t)(task * 16 + fr) * D + 8 * fq; const bf16* bp = WIF + (size_t)fr * D + 8 * fq;
        f32x4v acc[4];
#pragma unroll
        for (int u = 0; u < 4; ++u) acc[u] = (f32x4v){0.f, 0.f, 0.f, 0.f};
        for (int ks = 0; ks < 128; ks += 16) {
            bf16x8v a[16], b[16];
#pragma unroll
            for (int u = 0; u < 16; ++u) { a[u] = *(const GAS bf16x8v*)(ap + 32 * (ks + u)); b[u] = *(const GAS bf16x8v*)(bp + 32 * (ks + u)); }
#pragma unroll
            for (int u = 0; u < 16; ++u) acc[u & 3] = __builtin_amdgcn_mfma_f32_16x16x32_bf16(a[u], b[u], acc[u & 3], 0, 0, 0);
        }
        const f32x4v r = (acc[0] + acc[1]) + (acc[2] + acc[3]);
#pragma unroll
        for (int i = 0; i < 4; ++i) IFG[(size_t)(task * 16 + 4 * fq + i) * 16 + fr] = r[i];
    }
}
__device__ __forceinline__ float dot8(const v4u q, const v4u k) {
    return (bflo(q.x) * bflo(k.x) + bfhi(q.x) * bfhi(k.x)) + (bflo(q.y) * bflo(k.y) + bfhi(q.y) * bfhi(k.y)) + (bflo(q.z) * bflo(k.z) + bfhi(q.z) * bfhi(k.z)) + (bflo(q.w) * bflo(k.w) + bfhi(q.w) * bfhi(k.w));
}
__device__ __forceinline__ float alibi_slope(int g, int h) { const float x = g == 0 ? 0.25f * (h + 1) : g == 1 ? 2.0f + 0.25f * (h + 1) : 4.0f + 0.5f * (h + 1); return exp2f(-x); }
__device__ __forceinline__ void attn_naive(const Ctx& F, const bf16* QKV, bf16* AO, float* LSE) {
    const int gw = F.bx * NWAVES + F.wave, NGW = F.G * NWAVES, lane = F.lane;
    for (int it = gw; it < 3 * 2 * 8 * 256; it += NGW) {
        const int g = it / 4096, rem = it % 4096, b = rem / 2048, rem2 = rem % 2048, h = rem2 / 256, ck = rem2 % 256;
        const int sh = 2 * g, d = 1 << sh, L = 8192 >> sh, pos0 = ck * 32, r = pos0 / L, j0 = pos0 % L;
        const size_t seq = (size_t)g * pg8::ATT_G + (((size_t)(b * 8 + h) << 13) + (size_t)r * L) * 128;
        const bf16* Qs = QKV + seq; const bf16* Ks = QKV + pg8::ATT_T + seq; const bf16* Vs = QKV + 2 * pg8::ATT_T + seq;
        const float sd = alibi_slope(g, h) * (float)d, scale = 0.08838834764831845f;
        for (int qi = 0; qi < 32; ++qi) {
            const int j = j0 + qi;
            const bool v0 = (j - lane) >= 0, v1 = (j - lane - 64) >= 0, v2 = (lane == 0) && (j - 128 >= 0);
            const GAS v4u* qp = (const GAS v4u*)(Qs + (size_t)j * 128);
            const GAS v4u* k0 = (const GAS v4u*)(Ks + (size_t)(v0 ? j - lane : 0) * 128);
            const GAS v4u* k1 = (const GAS v4u*)(Ks + (size_t)(v1 ? j - lane - 64 : 0) * 128);
            const GAS v4u* k2 = (const GAS v4u*)(Ks + (size_t)(v2 ? j - 128 : 0) * 128);
            float s0 = 0.f, s1 = 0.f, s2 = 0.f;
#pragma unroll 4
            for (int c = 0; c < 16; ++c) { const v4u qv = qp[c]; s0 += dot8(qv, k0[c]); s1 += dot8(qv, k1[c]); s2 += dot8(qv, k2[c]); }
            const float NEGI = -__builtin_inff();
            s0 = v0 ? s0 * scale - sd * (float)lane : NEGI; s1 = v1 ? s1 * scale - sd * (float)(lane + 64) : NEGI; s2 = v2 ? s2 * scale - sd * 128.f : NEGI;
            const float mx = wave_max(fmaxf(s0, fmaxf(s1, s2)));
            const float p0 = v0 ? __expf(s0 - mx) : 0.f, p1 = v1 ? __expf(s1 - mx) : 0.f, p2 = v2 ? __expf(s2 - mx) : 0.f;
            const float sum = wave_sum(p0 + p1 + p2);
            const int nk = (j < 128 ? j : 128) + 1;
            float a0 = 0.f, a1 = 0.f;
            for (int rel = 0; rel < nk; ++rel) {
                const float p = rel < 64 ? __shfl(p0, rel) : (rel < 128 ? __shfl(p1, rel - 64) : __shfl(p2, 0));
                const unsigned vv = ((const GAS unsigned*)(Vs + (size_t)(j - rel) * 128))[lane];
                a0 += p * bflo(vv); a1 += p * bfhi(vv);
            }
            const float inv = 1.0f / sum;
            const size_t m = (size_t)b * T + r + (size_t)d * j;
            ((GAS unsigned*)(AO + (size_t)g * pg8::ATT_G + m * 1024 + h * 128))[lane] = pk2(a0 * inv, a1 * inv);
            if (lane == 0) LSE[((size_t)g * M + m) * 8 + h] = mx + __logf(sum);
        }
    }
}
constexpr int AV_PITCH = 272;
constexpr int AV_WAVE_BYTES = 32 * AV_PITCH;
__device__ __forceinline__ void attn_fast(const Ctx& F, const bf16* QKV, bf16* AO, float* LSE, const float* w_up, const float* w_down, bf16* WUP, bf16* WDOWN, const float* g_mlp, int wg_rank, int wg_count) {
    const int gw = wg_rank * NWAVES + F.wave, NGW = wg_count * NWAVES, lane = F.lane, c = lane & 31, hi = lane >> 5;
    LAS unsigned char* vimg = F.lds + RING_OFF + F.wave * AV_WAVE_BYTES;
    LAS float* tscr = (LAS float*)(F.lds + RING_OFF + NWAVES * AV_WAVE_BYTES + F.wave * 8448);
    static_assert(NWAVES * (AV_WAVE_BYTES + 8448) <= LDSCTL_OFF, "per-wave V images + copy tiles inside the phase scratch");
    const int trb = (4 * hi + ((lane & 15) >> 2)) * AV_PITCH + ((lane >> 4) & 1) * 32 + (lane & 3) * 8;
    const int strow = lane >> 4, stcol = (lane & 15) * 16;
    for (int it = gw; it < 3 * 2 * 8 * 256; it += NGW) {
        const int g = it / 4096, rem = it % 4096, b = rem / 2048, rem2 = rem % 2048, h = rem2 / 256, ck = rem2 % 256;
        const int sh = 2 * g, d = 1 << sh, L = 8192 >> sh, pos0 = ck * 32, r = pos0 / L, q0 = pos0 % L;
        const size_t seq = (size_t)g * pg8::ATT_G + (((size_t)(b * 8 + h) << 13) + (size_t)r * L) * 128;
        const bf16* Qs = QKV + seq; const bf16* Ks = QKV + pg8::ATT_T + seq; const bf16* Vs = QKV + 2 * pg8::ATT_T + seq;
        const float sdl = alibi_slope(g, h) * (float)d * 1.4426950408889634f, scl = 0.08838834764831845f * 1.4426950408889634f;
        const int kb_lo = q0 >= 128 ? 0 : (128 - q0) >> 5;
        const int kbase = q0 - 128;
        bf16x8v qf[8];
#pragma unroll
        for (int s = 0; s < 8; ++s) qf[s] = *(const GAS bf16x8v*)(Qs + (size_t)(q0 + c) * 128 + 16 * s + 8 * hi);
        f32x16 S[5];
#pragma unroll
        for (int kb = 0; kb < 5; ++kb) {
#pragma unroll
            for (int q = 0; q < 16; ++q) S[kb][q] = 0.f;
            if (kb >= kb_lo) {
                const bf16* kp = Ks + (size_t)(kbase + 32 * kb + c) * 128 + 8 * hi;
#pragma unroll
                for (int s = 0; s < 8; ++s) { const bf16x8v kf = *(const GAS bf16x8v*)(kp + 16 * s); S[kb] = __builtin_amdgcn_mfma_f32_32x32x16_bf16(kf, qf[s], S[kb], 0, 0, 0); }
            }
            asm volatile("" ::: "memory");
        }
        int lo_ = lane; asm volatile("" : "+v"(lo_));
        const int dd = (lo_ & 31) - 4 * (lo_ >> 5);
        const float base = -sdl * (float)dd, nsdl = -sdl;
        const float NEGI = -__builtin_inff(); float mx = NEGI;
#pragma unroll
        for (int kb = 0; kb < 5; ++kb)
#pragma unroll
            for (int q = 0; q < 16; ++q) { const int cq = (q & 3) + 8 * (q >> 2);
                float t = __builtin_fmaf(S[kb][q], scl, __builtin_fmaf(nsdl, (float)(128 - 32 * kb - cq), base));
                const bool ok = (kb >= kb_lo) && (kb != 0 || dd <= cq) && (kb != 4 || dd >= cq);
                t = ok ? t : NEGI; S[kb][q] = t; mx = fmaxf(mx, t); }
        mx = fmaxf(mx, __shfl_xor(mx, 32));
        float lsum = 0.f;
        bf16x8v pf[5][2];
#pragma unroll
        for (int kb = 0; kb < 5; ++kb) {
#pragma unroll
            for (int q = 0; q < 16; ++q) { const float p = __builtin_amdgcn_exp2f(S[kb][q] - mx); S[kb][q] = p; lsum += p; }
#pragma unroll
            for (int s2 = 0; s2 < 2; ++s2) {
                pg8::u32x4 pw; pw.x = pg8::cvt_pk_bf16(S[kb][8 * s2 + 0], S[kb][8 * s2 + 1]); pw.y = pg8::cvt_pk_bf16(S[kb][8 * s2 + 2], S[kb][8 * s2 + 3]);
                pw.z = pg8::cvt_pk_bf16(S[kb][8 * s2 + 4], S[kb][8 * s2 + 5]); pw.w = pg8::cvt_pk_bf16(S[kb][8 * s2 + 6], S[kb][8 * s2 + 7]);
                pf[kb][s2] = __builtin_bit_cast(bf16x8v, pw); }
        }
        lsum += __shfl_xor(lsum, 32);
        __builtin_amdgcn_sched_barrier(0);
        f32x16 o[4];
#pragma unroll
        for (int db = 0; db < 4; ++db)
#pragma unroll
            for (int q = 0; q < 16; ++q) o[db][q] = 0.f;
#pragma unroll
        for (int kb = 0; kb < 5; ++kb) {
            asm volatile("" ::: "memory");
            if (kb >= kb_lo) {
                LAS unsigned char* img = vimg;
                const bf16* vp = Vs + (size_t)(kbase + 32 * kb) * 128;
#pragma unroll
                for (int i = 0; i < 8; ++i) { const v4u w = *(const GAS v4u*)(vp + (size_t)(4 * i + strow) * 128 + (stcol >> 1)); *(LAS v4u*)(img + (4 * i + strow) * AV_PITCH + stcol) = w; }
#pragma unroll
                for (int s2 = 0; s2 < 2; ++s2) {
#pragma unroll
                    for (int db = 0; db < 4; ++db) {
                        const s16x4v lo = __builtin_amdgcn_ds_read_tr16_b64_v4i16((LAS s16x4v*)(img + trb + (16 * s2) * AV_PITCH + 64 * db));
                        const s16x4v hv = __builtin_amdgcn_ds_read_tr16_b64_v4i16((LAS s16x4v*)(img + trb + (16 * s2 + 8) * AV_PITCH + 64 * db));
                        const bf16x8v vf = __builtin_shufflevector(lo, hv, 0, 1, 2, 3, 4, 5, 6, 7);
                        o[db] = __builtin_amdgcn_mfma_f32_32x32x16_bf16(vf, pf[kb][s2], o[db], 0, 0, 0);
                    }
                }
            }
        }
        const float inv = 1.0f / lsum;
        const size_t m = (size_t)b * T + r + (size_t)d * (q0 + c);
        bf16* orow = AO + (size_t)g * pg8::ATT_G + m * 1024 + h * 128;
#pragma unroll
        for (int db = 0; db < 4; ++db)
#pragma unroll
            for (int kp = 0; kp < 2; ++kp) {
                unsigned ax = pg8::cvt_pk_bf16(o[db][8 * kp] * inv, o[db][8 * kp + 1] * inv), ay = pg8::cvt_pk_bf16(o[db][8 * kp + 2] * inv, o[db][8 * kp + 3] * inv);
                unsigned bx = pg8::cvt_pk_bf16(o[db][8 * kp + 4] * inv, o[db][8 * kp + 5] * inv), by = pg8::cvt_pk_bf16(o[db][8 * kp + 6] * inv, o[db][8 * kp + 7] * inv);
                { const auto r = __builtin_amdgcn_permlane32_swap(ax, bx, false, false); ax = r[0]; bx = r[1]; }
                { const auto r = __builtin_amdgcn_permlane32_swap(ay, by, false, false); ay = r[0]; by = r[1]; }
                *(GAS v4u*)(orow + 32 * db + 16 * kp + 8 * hi) = (v4u){ax, ay, bx, by}; }
        if (hi == 0) LSE[((size_t)g * M + m) * 8 + h] = (mx + __builtin_amdgcn_logf(lsum)) * 0.6931471805599453f;
        for (int ci = (it * 16) / 3; ci < ((it + 1) * 16) / 3; ++ci) {
            if (ci < 64 * 512) p0_transpose_item(w_up, D, FF, 0, 512, 32, WUP, 0, tscr, ci, lane, g_mlp);
            else p0_transpose_item(w_down, FF, D, 0, 128, 32, WDOWN, 0, tscr, ci - 64 * 512, lane);
        }
    }
}
__device__ __forceinline__ float softcap15(float x) { return 15.0f * tanhf(x * (1.0f / 15.0f)); }
__device__ __forceinline__ void mlstm_naive(const Ctx& F, const bf16* MQ, const bf16* MK, const bf16* MV, const float* IFG, const float* b_i, const float* b_f, bf16* HRAW) {
    LAS bf16* qs = (LAS bf16*)(F.lds + RING_OFF); LAS bf16* ks = qs + 64 * 256; LAS bf16* vs = ks + 64 * 256;
    LAS float* gi = (LAS float*)(vs + 64 * 32); LAS float* gf = gi + 64; LAS float* red = gf + 64; LAS float* rden = red + 1024;
    const int tid = F.tid, j = tid & 31, eg = tid >> 5;
    for (int item = F.bx; item < 256; item += F.G) {
        const int b = item >> 7, h = (item >> 4) & 7, vsl = item & 15;
        float C[16], n[16];
#pragma unroll
        for (int e = 0; e < 16; ++e) { C[e] = 0.f; n[e] = 0.f; }
        const float bi = b_i[h], bfv = b_f[h];
        for (int chunk = 0; chunk < 128; ++chunk) {
            const size_t m0 = (size_t)b * T + chunk * 64;
            __syncthreads();
#pragma unroll
            for (int i = 0; i < 4; ++i) { const int idx = tid + 512 * i, row = idx >> 5, c16 = idx & 31;
                *(LAS v4u*)(qs + row * 256 + c16 * 8) = *(const GAS v4u*)(MQ + (m0 + row) * 2048 + h * 256 + c16 * 8);
                *(LAS v4u*)(ks + row * 256 + c16 * 8) = *(const GAS v4u*)(MK + (m0 + row) * 2048 + h * 256 + c16 * 8); }
            if (tid < 256) { const int row = tid >> 2, c = tid & 3; *(LAS v4u*)(vs + row * 32 + c * 8) = *(const GAS v4u*)(MV + (m0 + row) * 4096 + h * 512 + vsl * 32 + c * 8); }
            if (tid < 64) { const float ri = IFG[(m0 + tid) * 16 + h] + bi, rf = IFG[(m0 + tid) * 16 + 8 + h] + bfv;
                gi[tid] = __expf(softcap15(ri)); gf[tid] = 1.0f / (1.0f + __expf(-softcap15(rf))); }
            __syncthreads();
            for (int t = 0; t < 64; ++t) {
                const float f = gf[t], ig = gi[t], vj = bf2f(vs[t * 32 + j]);
                const v4u kw0 = *(const LAS v4u*)(ks + t * 256 + eg * 16), kw1 = *(const LAS v4u*)(ks + t * 256 + eg * 16 + 8);
                const v4u qw0 = *(const LAS v4u*)(qs + t * 256 + eg * 16), qw1 = *(const LAS v4u*)(qs + t * 256 + eg * 16 + 8);
                const unsigned kw[8] = {kw0.x, kw0.y, kw0.z, kw0.w, kw1.x, kw1.y, kw1.z, kw1.w}, qw[8] = {qw0.x, qw0.y, qw0.z, qw0.w, qw1.x, qw1.y, qw1.z, qw1.w};
                float pn = 0.f, pd = 0.f;
#pragma unroll
                for (int e2 = 0; e2 < 8; ++e2) {
                    { const float ik = ig * bflo(kw[e2]), qq = bflo(qw[e2]); C[2 * e2] = f * C[2 * e2] + ik * vj; n[2 * e2] = f * n[2 * e2] + ik; pn += qq * C[2 * e2]; pd += qq * n[2 * e2]; }
                    { const float ik = ig * bfhi(kw[e2]), qq = bfhi(qw[e2]); C[2 * e2 + 1] = f * C[2 * e2 + 1] + ik * vj; n[2 * e2 + 1] = f * n[2 * e2 + 1] + ik; pn += qq * C[2 * e2 + 1]; pd += qq * n[2 * e2 + 1]; }
                }
                const int buf = t & 1;
                red[buf * 512 + eg * 32 + j] = pn; if (j == 0) rden[buf * 16 + eg] = pd;
                __syncthreads();
                if (tid < 32) { float num = 0.f, den = 0.f;
#pragma unroll
                    for (int q = 0; q < 16; ++q) { num += red[buf * 512 + q * 32 + tid]; den += rden[buf * 16 + q]; }
                    HRAW[(m0 + t) * 4096 + h * 512 + vsl * 32 + tid] = (bf16)f2bf(num / fmaxf(fabsf(den), 1.0f)); }
            }
        }
    }
}
namespace ml {
constexpr int QP = 528;
constexpr int NVT = 4, NCT = NVT + 1, VW = 16 * NVT;
constexpr int VP = VW * 2 + 16;
constexpr int O_Q = 0, O_K = 64 * QP, O_CT = 2 * 64 * QP, O_V = O_CT + 16 * NCT * QP, O_WV = O_V + 64 * VP, O_HI = O_WV + 64 * VP, HIP = VW + 1;
constexpr int GSZ = 1536;
constexpr int O_G = O_HI + 64 * HIP * 4, O_DI = O_G + 2 * GSZ, O_END = O_DI + 256;
static_assert(16 * VP <= 16 * HIP * 4 && ((16 * HIP * 4) % 16) == 0, "output transpose tile inside a wave's 16 H_intra rows");
static_assert(O_END <= LDSCTL_OFF && (O_HI % 16) == 0 && (O_G % 16) == 0 && (GSZ % 16) == 0 && (O_V % 16) == 0 && (VP % 16) == 0, "mLSTM LDS map");
}
#define ML_DPPF(old, src, ctrl, rmask) __builtin_bit_cast(float, __builtin_amdgcn_update_dpp(__builtin_bit_cast(int, (float)(old)), __builtin_bit_cast(int, (float)(src)), ctrl, rmask, 0xf, false))
__device__ __forceinline__ float lane_scan_add(float v) {
    v += ML_DPPF(0.f, v, 0x111, 0xf); v += ML_DPPF(0.f, v, 0x112, 0xf); v += ML_DPPF(0.f, v, 0x114, 0xf); v += ML_DPPF(0.f, v, 0x118, 0xf);
    v += ML_DPPF(0.f, v, 0x142, 0xa); v += ML_DPPF(0.f, v, 0x143, 0xc); return v;
}
__device__ __forceinline__ float lane_scan_max(float v) {
    const float NI = -__builtin_inff();
    v = fmaxf(v, ML_DPPF(NI, v, 0x111, 0xf)); v = fmaxf(v, ML_DPPF(NI, v, 0x112, 0xf)); v = fmaxf(v, ML_DPPF(NI, v, 0x114, 0xf)); v = fmaxf(v, ML_DPPF(NI, v, 0x118, 0xf));
    v = fmaxf(v, ML_DPPF(NI, v, 0x142, 0xa)); v = fmaxf(v, ML_DPPF(NI, v, 0x143, 0xc)); return v;
}
__device__ __forceinline__ float softcap15_fast(float x) { const float e = __expf(x * (2.0f / 15.0f)); return 15.0f - 30.0f * __builtin_amdgcn_rcpf(e + 1.0f); }
__device__ __forceinline__ bf16x8v pack8v(float a0, float a1, float a2, float a3, float a4, float a5, float a6, float a7) {
    pg8::u32x4 w; w.x = pg8::cvt_pk_bf16(a0, a1); w.y = pg8::cvt_pk_bf16(a2, a3); w.z = pg8::cvt_pk_bf16(a4, a5); w.w = pg8::cvt_pk_bf16(a6, a7); return __builtin_bit_cast(bf16x8v, w);
}
__device__ __forceinline__ bf16x8v tr_pair(LAS unsigned char* p0, LAS unsigned char* p1) {
    const s16x4v lo = __builtin_amdgcn_ds_read_tr16_b64_v4i16((LAS s16x4v*)p0), hv = __builtin_amdgcn_ds_read_tr16_b64_v4i16((LAS s16x4v*)p1);
    return __builtin_shufflevector(lo, hv, 0, 1, 2, 3, 4, 5, 6, 7);
}
#define ML_LDS_BARRIER() do { asm volatile("s_waitcnt lgkmcnt(0)" ::: "memory"); __builtin_amdgcn_s_barrier(); asm volatile("" ::: "memory"); } while (0)
__device__ __forceinline__ void mlstm_gates(float gi_pre, float gf_pre, float bi, float bfv, float& m_prev, int lane, LAS float* G) {
    const float li = softcap15_fast(gi_pre + bi), xf = softcap15_fast(gf_pre + bfv), lf = -(fmaxf(-xf, 0.f) + __logf(1.0f + __expf(-fabsf(xf))));
    const float bb = lane_scan_add(lf), a = li - bb, pm = lane_scan_max(a);
    const float Mt = fmaxf(m_prev, pm), M63 = __shfl(Mt, 63), b63 = __shfl(bb, 63);
    G[lane] = a * 1.4426950408889634f; G[64 + lane] = Mt * 1.4426950408889634f;
    G[128 + lane] = __expf(m_prev - Mt); G[192 + lane] = __expf(-(bb + Mt)); G[256 + lane] = __expf(a - M63);
    if (lane == 0) G[320] = __expf(m_prev - M63);
    m_prev = b63 + M63;
}
__device__ __forceinline__ void mlstm_fast(const Ctx& F, const bf16* MQ, const bf16* MK, const bf16* MV, const float* IFG, const float* b_i, const float* b_f, bf16* HRAW, int wg_rank, int wg_count) {
    using namespace ml;
    constexpr int NITEM = 16 * (512 / VW);
    LAS unsigned char* L = F.lds + RING_OFF;
    const int tid = F.tid, lane = F.lane, w = F.wave, fr = lane & 15, fq = lane >> 4;
    LAS float* diL = (LAS float*)(L + O_DI); LAS float* hiL = (LAS float*)(L + O_HI);
    const int trq = (lane & 15) >> 2, trp = lane & 3;
    for (int item = wg_rank; item < NITEM; item += wg_count) {
        const int bh = (item & 3) * 4 + (item >> 5), vsl = (item >> 2) & 7, b = bh >> 3, h = bh & 7;
        const float bi = b_i[h], bfv = b_f[h];
        const bf16* qg = MQ + (size_t)b * T * 2048 + h * 256; const bf16* kg = MK + (size_t)b * T * 2048 + h * 256;
        const bf16* vg = MV + (size_t)b * T * 4096 + h * 512 + vsl * VW; const float* ig = IFG + (size_t)b * T * 16 + h;
        bf16* hg = HRAW + (size_t)b * T * 4096 + h * 512 + vsl * VW;
        __syncthreads();
        const int ne = 2, e0 = 2 * w;
        f32x4v Cm[2][NCT];
#pragma unroll
        for (int x = 0; x < 2; ++x)
#pragma unroll
            for (int y = 0; y < NCT; ++y) Cm[x][y] = (f32x4v){0.f, 0.f, 0.f, 0.f};
        for (int i = tid; i < 16 * NCT * QP / 16; i += 512) *(LAS v4u*)(L + O_CT + i * 16) = (v4u){0u, 0u, 0u, 0u};
        float m_prev = -1e30f;
        v4u pq[4], pk[4], pv; float gi_pre = 0.f, gf_pre = 0.f;
#pragma unroll
        for (int i = 0; i < 4; ++i) { const int idx = tid + 512 * i, row = idx >> 5, c16 = idx & 31;
            pq[i] = *(const GAS v4u*)(qg + (size_t)row * 2048 + c16 * 8); pk[i] = *(const GAS v4u*)(kg + (size_t)row * 2048 + c16 * 8); }
        pv = *(const GAS v4u*)(vg + (size_t)(tid >> 3) * 4096 + (tid & 7) * 8);
        if (w == 0) { mlstm_gates(ig[(size_t)lane * 16], ig[(size_t)lane * 16 + 8], bi, bfv, m_prev, lane, (LAS float*)(L + O_G));
                      gi_pre = ig[(size_t)(64 + lane) * 16]; gf_pre = ig[(size_t)(64 + lane) * 16 + 8]; }
        ML_LDS_BARRIER();
        for (int chunk = 0; chunk < 128; ++chunk) {
            const size_t m0 = (size_t)chunk * 64;
            LAS float* G = (LAS float*)(L + O_G + (chunk & 1) * GSZ);
            LAS float* a2L = G; LAS float* m2L = G + 64; LAS float* winL = G + 128; LAS float* clL = G + 192; LAS float* wkL = G + 256;
#pragma unroll
            for (int i = 0; i < 4; ++i) { const int idx = tid + 512 * i, row = idx >> 5, c16 = idx & 31;
                *(LAS v4u*)(L + O_Q + row * QP + c16 * 16) = pq[i]; *(LAS v4u*)(L + O_K + row * QP + c16 * 16) = pk[i]; }
            { const int s = tid >> 3, cc = tid & 7; const float wks = wkL[s];
              *(LAS v4u*)(L + O_V + s * VP + cc * 16) = pv;
              pg8::u32x4 o; o.x = pg8::cvt_pk_bf16(bflo(pv.x) * wks, bfhi(pv.x) * wks); o.y = pg8::cvt_pk_bf16(bflo(pv.y) * wks, bfhi(pv.y) * wks);
              o.z = pg8::cvt_pk_bf16(bflo(pv.z) * wks, bfhi(pv.z) * wks); o.w = pg8::cvt_pk_bf16(bflo(pv.w) * wks, bfhi(pv.w) * wks);
              *(LAS pg8::u32x4*)(L + O_WV + s * VP + cc * 16) = o; }
            ML_LDS_BARRIER();
            if (chunk + 1 < 128) { const size_t m1 = m0 + 64;
#pragma unroll
                for (int i = 0; i < 4; ++i) { const int idx = tid + 512 * i, row = idx >> 5, c16 = idx & 31;
                    pq[i] = *(const GAS v4u*)(qg + (m1 + row) * 2048 + c16 * 8); pk[i] = *(const GAS v4u*)(kg + (m1 + row) * 2048 + c16 * 8); }
                pv = *(const GAS v4u*)(vg + (m1 + (tid >> 3)) * 4096 + (tid & 7) * 8); }
            f32x4v Hq[NCT];
#pragma unroll
            for (int y = 0; y < NCT; ++y) Hq[y] = (f32x4v){0.f, 0.f, 0.f, 0.f};
            if (w < 4) {
                const int ti = w;
                bf16x8v qf[8];
#pragma unroll
                for (int ke = 0; ke < 8; ++ke) qf[ke] = *(const LAS bf16x8v*)(L + O_Q + (16 * ti + fr) * QP + 16 * fq + 64 * ke);
                f32x4v St[4];
#pragma unroll
                for (int sj = 0; sj < 4; ++sj) {
                    St[sj] = (f32x4v){0.f, 0.f, 0.f, 0.f};
                    if (sj <= ti) {
                    bf16x8v kf[8];
#pragma unroll
                    for (int ke = 0; ke < 8; ++ke) kf[ke] = *(const LAS bf16x8v*)(L + O_K + (16 * sj + fr) * QP + 16 * fq + 64 * ke);
                    f32x4v acc0 = (f32x4v){0.f, 0.f, 0.f, 0.f}, acc1 = (f32x4v){0.f, 0.f, 0.f, 0.f};
#pragma unroll
                    for (int ke = 0; ke < 8; ke += 2) { acc0 = __builtin_amdgcn_mfma_f32_16x16x32_bf16(kf[ke], qf[ke], acc0, 0, 0, 0); acc1 = __builtin_amdgcn_mfma_f32_16x16x32_bf16(kf[ke + 1], qf[ke + 1], acc1, 0, 0, 0); }
                    St[sj] = acc0 + acc1; }
                }
                const float m2t = m2L[16 * ti + fr]; float dsum = 0.f;
#pragma unroll
                for (int sj = 0; sj < 4; ++sj) {
                    const f32x4v a4 = *(const LAS f32x4v*)(a2L + 16 * sj + 4 * fq);
#pragma unroll
                    for (int i = 0; i < 4; ++i) { const bool ok = (sj < ti) || (sj == ti && 4 * fq + i <= fr);
                        const float v = St[sj][i] * __builtin_amdgcn_exp2f(fminf(a4[i] - m2t, 0.f)); St[sj][i] = ok ? v : 0.f; dsum += St[sj][i]; }
                }
                dsum += __shfl_xor(dsum, 16); dsum += __shfl_xor(dsum, 32);
                if (fq == 0) diL[16 * ti + fr] = dsum;
                f32x4v Hi[NVT];
#pragma unroll
                for (int vt = 0; vt < NVT; ++vt) Hi[vt] = (f32x4v){0.f, 0.f, 0.f, 0.f};
#pragma unroll
                for (int p = 0; p < 2; ++p) if (2 * p <= ti) {
                    const bf16x8v af = pack8v(St[2 * p][0], St[2 * p][1], St[2 * p][2], St[2 * p][3], St[2 * p + 1][0], St[2 * p + 1][1], St[2 * p + 1][2], St[2 * p + 1][3]);
#pragma unroll
                    for (int vt = 0; vt < NVT; ++vt) { LAS unsigned char* vb = L + O_V + (32 * p + 4 * fq + trq) * VP + 32 * vt + 8 * trp;
                        Hi[vt] = __builtin_amdgcn_mfma_f32_16x16x32_bf16(af, tr_pair(vb, vb + 16 * VP), Hi[vt], 0, 0, 0); }
                }
#pragma unroll
                for (int vt = 0; vt < NVT; ++vt)
#pragma unroll
                    for (int i = 0; i < 4; ++i) hiL[(16 * ti + 4 * fq + i) * HIP + 16 * vt + fr] = Hi[vt][i];
            } else {
                const int ti = w - 4;
                bf16x8v qf[8];
#pragma unroll
                for (int ke = 0; ke < 8; ++ke) qf[ke] = *(const LAS bf16x8v*)(L + O_Q + (16 * ti + fr) * QP + 16 * fq + 64 * ke);
#pragma unroll
                for (int y = 0; y < NCT; ++y) {
                    bf16x8v cf[8];
#pragma unroll
                    for (int ke = 0; ke < 8; ++ke) cf[ke] = *(const LAS bf16x8v*)(L + O_CT + (16 * y + fr) * QP + 16 * fq + 64 * ke);
                    f32x4v ha = (f32x4v){0.f, 0.f, 0.f, 0.f}, hb = ha;
#pragma unroll
                    for (int ke = 0; ke < 8; ke += 2) { ha = __builtin_amdgcn_mfma_f32_16x16x32_bf16(qf[ke], cf[ke], ha, 0, 0, 0); hb = __builtin_amdgcn_mfma_f32_16x16x32_bf16(qf[ke + 1], cf[ke + 1], hb, 0, 0, 0); }
                    Hq[y] = ha + hb;
                }
            }
            ML_LDS_BARRIER();
            if (w >= 4) {
                const int ti = w - 4, t0 = 16 * ti + 4 * fq;
                const f32x4v wi = *(const LAS f32x4v*)(winL + t0), di = *(const LAS f32x4v*)(diL + t0), cl = *(const LAS f32x4v*)(clL + t0);
                f32x4v qn4;
#pragma unroll
                for (int i = 0; i < 4; ++i) qn4[i] = __shfl(Hq[NVT][i], lane & 48);
                float hv[4][NVT];
#pragma unroll
                for (int i = 0; i < 4; ++i) { const float den = wi[i] * qn4[i] + di[i], rd = __builtin_amdgcn_rcpf(fmaxf(fabsf(den), cl[i]));
#pragma unroll
                    for (int vt = 0; vt < NVT; ++vt) hv[i][vt] = (wi[i] * Hq[vt][i] + hiL[(t0 + i) * HIP + 16 * vt + fr]) * rd; }
                LAS unsigned char* ot = L + O_HI + (16 * ti) * HIP * 4;
                asm volatile("" ::: "memory");
#pragma unroll
                for (int i = 0; i < 4; ++i) {
#pragma unroll
                    for (int vt = 0; vt < NVT; ++vt) *(LAS bf16*)(ot + (4 * fq + i) * VP + (16 * vt + fr) * 2) = (bf16)(pg8::cvt_pk_bf16(hv[i][vt], 0.f) & 0xffffu); }
                LDS_WAIT(); asm volatile("" ::: "memory");
#pragma unroll
                for (int pz = 0; pz < VW / 32; ++pz) { const int pc = lane + 64 * pz, orow = pc / (VW / 8), oc = (pc % (VW / 8)) * 8;
                    *(GAS v4u*)(hg + (m0 + 16 * ti + orow) * 4096 + oc) = *(const LAS v4u*)(ot + orow * VP + oc * 2); }
            }
            { const float decay = G[320];
              bf16x8v kf[2][2], wf[2][NCT];
#pragma unroll
              for (int ks = 0; ks < 2; ++ks) {
#pragma unroll
                  for (int x = 0; x < 2; ++x) if (x < ne) { LAS unsigned char* kb_ = L + O_K + (32 * ks + 8 * fq + trq) * QP + (16 * (e0 + x)) * 2 + 8 * trp; kf[ks][x] = tr_pair(kb_, kb_ + 4 * QP); }
#pragma unroll
                  for (int y = 0; y < NVT; ++y) { LAS unsigned char* wb_ = L + O_WV + (32 * ks + 8 * fq + trq) * VP + 32 * y + 8 * trp; wf[ks][y] = tr_pair(wb_, wb_ + 4 * VP); }
                  const f32x4v k0 = *(const LAS f32x4v*)(wkL + 32 * ks + 8 * fq), k1 = *(const LAS f32x4v*)(wkL + 32 * ks + 8 * fq + 4);
                  const bf16x8v wkf = pack8v(k0[0], k0[1], k0[2], k0[3], k1[0], k1[1], k1[2], k1[3]);
                  wf[ks][NVT] = (fr == 0) ? wkf : (bf16x8v){0, 0, 0, 0, 0, 0, 0, 0};
              }
#pragma unroll
              for (int x = 0; x < 2; ++x) if (x < ne) {
#pragma unroll
                  for (int y = 0; y < NCT; ++y) { f32x4v c = Cm[x][y] * decay;
                      c = __builtin_amdgcn_mfma_f32_16x16x32_bf16(kf[0][x], wf[0][y], c, 0, 0, 0); c = __builtin_amdgcn_mfma_f32_16x16x32_bf16(kf[1][x], wf[1][y], c, 0, 0, 0); Cm[x][y] = c;
                      v2u o; o.x = pg8::cvt_pk_bf16(c[0], c[1]); o.y = pg8::cvt_pk_bf16(c[2], c[3]);
                      *(LAS v2u*)(L + O_CT + (16 * y + fr) * QP + (16 * (e0 + x) + 4 * fq) * 2) = o; } }
            }
            if (w == 0 && chunk + 1 < 128) {
                mlstm_gates(gi_pre, gf_pre, bi, bfv, m_prev, lane, (LAS float*)(L + O_G + ((chunk + 1) & 1) * GSZ));
                if (chunk + 2 < 128) { gi_pre = ig[(m0 + 128 + lane) * 16]; gf_pre = ig[(m0 + 128 + lane) * 16 + 8]; } }
            ML_LDS_BARRIER();
        }
    }
}
struct P3Args { const bf16* AO; const float* LSE; const bf16* HRAW; const bf16* MO; const float* g_mls; unsigned char *ATTQ, *MLSQ; float *SAA, *SAM; };
__device__ __forceinline__ unsigned q8(float x, float qs) { return (unsigned)(int)__builtin_rintf(fminf(fmaxf(x * qs, -127.f), 127.f)) & 255u; }
__device__ __forceinline__ v2u q8x8(const float (&v)[8], float qs) {
    v2u o; o.x = q8(v[0], qs) | (q8(v[1], qs) << 8) | (q8(v[2], qs) << 16) | (q8(v[3], qs) << 24); o.y = q8(v[4], qs) | (q8(v[5], qs) << 8) | (q8(v[6], qs) << 16) | (q8(v[7], qs) << 24); return o;
}
__device__ __forceinline__ void p3_mix(const Ctx& F, const P3Args& A) {
    const int gw = F.bx * NWAVES + F.wave, NGW = F.G * NWAVES, lane = F.lane;
    for (int m = gw; m < M; m += NGW) {
        float r[2][8]; float rmax = 0.f;
#pragma unroll
        for (int cc = 0; cc < 2; ++cc) { const int c8 = lane + 64 * cc, h = c8 >> 4;
            const float l0 = A.LSE[((size_t)0 * M + m) * 8 + h], l1 = A.LSE[((size_t)1 * M + m) * 8 + h], l2 = A.LSE[((size_t)2 * M + m) * 8 + h];
            const float mx = fmaxf(l0, fmaxf(l1, l2)); float w0 = __expf(l0 - mx), w1 = __expf(l1 - mx), w2 = __expf(l2 - mx); const float inv = 1.0f / (w0 + w1 + w2); w0 *= inv; w1 *= inv; w2 *= inv;
            const v4u a = *(const GAS v4u*)(A.AO + (size_t)m * 1024 + c8 * 8), b = *(const GAS v4u*)(A.AO + pg8::ATT_G + (size_t)m * 1024 + c8 * 8), c = *(const GAS v4u*)(A.AO + 2 * pg8::ATT_G + (size_t)m * 1024 + c8 * 8);
            r[cc][0] = w0 * bflo(a.x) + w1 * bflo(b.x) + w2 * bflo(c.x); r[cc][1] = w0 * bfhi(a.x) + w1 * bfhi(b.x) + w2 * bfhi(c.x);
            r[cc][2] = w0 * bflo(a.y) + w1 * bflo(b.y) + w2 * bflo(c.y); r[cc][3] = w0 * bfhi(a.y) + w1 * bfhi(b.y) + w2 * bfhi(c.y);
            r[cc][4] = w0 * bflo(a.z) + w1 * bflo(b.z) + w2 * bflo(c.z); r[cc][5] = w0 * bfhi(a.z) + w1 * bfhi(b.z) + w2 * bfhi(c.z);
            r[cc][6] = w0 * bflo(a.w) + w1 * bflo(b.w) + w2 * bflo(c.w); r[cc][7] = w0 * bfhi(a.w) + w1 * bfhi(b.w) + w2 * bfhi(c.w);
#pragma unroll
            for (int q = 0; q < 8; ++q) rmax = fmaxf(rmax, fabsf(r[cc][q])); }
        rmax = wave_max(rmax); const float qs = rmax > 0.f ? 127.0f / rmax : 0.f;
        if (lane == 0) A.SAA[m] = rmax * (1.0f / 127.0f);
#pragma unroll
        for (int cc = 0; cc < 2; ++cc) *(GAS v2u*)(A.ATTQ + (size_t)m * 1024 + (lane + 64 * cc) * 8) = q8x8(r[cc], qs);
    }
    for (int m = gw; m < M; m += NGW) {
        v4u hw[8]; v2u ow[8];
#pragma unroll
        for (int h = 0; h < 8; ++h) { const size_t off = (size_t)m * 4096 + (size_t)h * 512 + lane * 8; hw[h] = *(const GAS v4u*)(A.HRAW + off); ow[h] = *(const GAS v2u*)((const GAS unsigned char*)A.MO + off); }
        float r[8][8]; float rmax = 0.f;
#pragma unroll
        for (int h = 0; h < 8; ++h) {
            const float hv[8] = {bflo(hw[h].x), bfhi(hw[h].x), bflo(hw[h].y), bfhi(hw[h].y), bflo(hw[h].z), bfhi(hw[h].z), bflo(hw[h].w), bfhi(hw[h].w)};
            const float ov[8] = {(float)(ow[h].x & 255u), (float)((ow[h].x >> 8) & 255u), (float)((ow[h].x >> 16) & 255u), (float)(ow[h].x >> 24), (float)(ow[h].y & 255u), (float)((ow[h].y >> 8) & 255u), (float)((ow[h].y >> 16) & 255u), (float)(ow[h].y >> 24)};
            float s = 0.f;
#pragma unroll
            for (int q = 0; q < 8; ++q) s += hv[q] * hv[q];
            const float rstd = 1.f / sqrtf(wave_sum(s) * (1.f / 512.f) + RMS_EPS);
            const f32x4 g0 = *(const GAS f32x4*)(A.g_mls + h * 512 + lane * 8), g1 = *(const GAS f32x4*)(A.g_mls + h * 512 + lane * 8 + 4);
            const float gg[8] = {g0.x, g0.y, g0.z, g0.w, g1.x, g1.y, g1.z, g1.w};
#pragma unroll
            for (int q = 0; q < 8; ++q) { r[h][q] = hv[q] * rstd * gg[q] * (ov[q] * (1.0f / 255.0f)); rmax = fmaxf(rmax, fabsf(r[h][q])); }
        }
        rmax = wave_max(rmax); const float qs = rmax > 0.f ? 127.0f / rmax : 0.f;
        if (lane == 0) A.SAM[m] = rmax * (1.0f / 127.0f);
#pragma unroll
        for (int h = 0; h < 8; ++h) *(GAS v2u*)(A.MLSQ + (size_t)m * 4096 + (size_t)h * 512 + lane * 8) = q8x8(r[h], qs);
    }
}
__device__ __forceinline__ void p45_quant_rows(const Ctx& F, const bf16* X, unsigned char* XQ, float* SAo) {
    const int gw = F.bx * NWAVES + F.wave, NGW = F.G * NWAVES, lane = F.lane;
    for (int m = gw; m < M; m += NGW) {
        v4u w[8]; float rmax = 0.f;
#pragma unroll
        for (int j = 0; j < 8; ++j) w[j] = *(const GAS v4u*)(X + (size_t)m * 4096 + (lane + 64 * j) * 8);
#pragma unroll
        for (int j = 0; j < 8; ++j) rmax = fmaxf(rmax, fmaxf(fmaxf(fmaxf(fabsf(bflo(w[j].x)), fabsf(bfhi(w[j].x))), fmaxf(fabsf(bflo(w[j].y)), fabsf(bfhi(w[j].y)))), fmaxf(fmaxf(fabsf(bflo(w[j].z)), fabsf(bfhi(w[j].z))), fmaxf(fabsf(bflo(w[j].w)), fabsf(bfhi(w[j].w))))));
        rmax = wave_max(rmax); const float qs = rmax > 0.f ? 127.0f / rmax : 0.f;
        if (lane == 0) SAo[m] = rmax * (1.0f / 127.0f);
#pragma unroll
        for (int j = 0; j < 8; ++j) { const float v[8] = {bflo(w[j].x), bfhi(w[j].x), bflo(w[j].y), bfhi(w[j].y), bflo(w[j].z), bfhi(w[j].z), bflo(w[j].w), bfhi(w[j].w)};
            *(GAS v2u*)(XQ + (size_t)m * 4096 + (lane + 64 * j) * 8) = q8x8(v, qs); }
    }
}
__device__ __forceinline__ void p6_rmsnorm(const Ctx& F, const float* h, const float* g, bf16* HN) {
    const int gw = F.bx * NWAVES + F.wave, NGW = F.G * NWAVES;
    for (int m = gw; m < M; m += NGW) rms_row_to_bf16(h + (size_t)m * D, g, HN + (size_t)m * D, F.lane);
}
__device__ __forceinline__ void p9_final(const Ctx& F, const bf16* H2, const float* SS, const float* g, float* out) {
    const size_t gt = (size_t)F.bx * (NWAVES * 64) + F.tid, NT = (size_t)F.G * NWAVES * 64;
    for (size_t i = gt; i < (size_t)M * D / 4; i += 2 * NT) {
        const size_t i2 = i + NT;
        const bool two = i2 < (size_t)M * D / 4;
        const v2u ha = *(const GAS v2u*)(H2 + i * 4); const v2u hb = two ? *(const GAS v2u*)(H2 + i2 * 4) : (v2u){0u, 0u};
        { const size_t m = i >> 10; const int c4 = (int)(i & 1023) * 4; const float rstd = 1.f / sqrtf(SS[m] * (1.f / D) + RMS_EPS); const f32x4 gg = *(const GAS f32x4*)(g + c4);
          f32x4 o; o.x = bflo(ha.x) * rstd * gg.x; o.y = bfhi(ha.x) * rstd * gg.y; o.z = bflo(ha.y) * rstd * gg.z; o.w = bfhi(ha.y) * rstd * gg.w; *(GAS f32x4*)(out + i * 4) = o; }
        if (two) { const size_t m = i2 >> 10; const int c4 = (int)(i2 & 1023) * 4; const float rstd = 1.f / sqrtf(SS[m] * (1.f / D) + RMS_EPS); const f32x4 gg = *(const GAS f32x4*)(g + c4);
          f32x4 o; o.x = bflo(hb.x) * rstd * gg.x; o.y = bfhi(hb.x) * rstd * gg.y; o.z = bflo(hb.y) * rstd * gg.z; o.w = bfhi(hb.y) * rstd * gg.w; *(GAS f32x4*)(out + i2 * 4) = o; }
    }
}

struct Args { const float* in[15]; float* out; unsigned char* ws; int ph_lo, ph_hi, li, pad; };
__global__ void __launch_bounds__(NWAVES * 64, 2) hybrid_fwd(Args args) {
    extern __shared__ __attribute__((aligned(16))) unsigned char lds[];
    Ctx F;
    F.lds = (LAS unsigned char*)lds;
    volatile LAS unsigned* MISC = (volatile LAS unsigned*)(F.lds + MISC_OFF);
    F.tid = threadIdx.x; F.lane = F.tid & 63; F.wave = __builtin_amdgcn_readfirstlane(F.tid >> 6);
    F.G = gridDim.x; F.bx = blockIdx.x;
    unsigned char* ws = args.ws;
    gu32* ctl = (gu32*)(ws + WS_CTL);
    const float* x = args.in[0]; const float* g_mix = args.in[1]; const float* w_in = args.in[2]; const float* b_ig = args.in[3]; const float* b_fg = args.in[4];
    const float* g_mls = args.in[5]; const float* w_attn = args.in[6]; const float* w_mlstm = args.in[7]; const float* w_gate = args.in[8]; const float* b_gate = args.in[9];
    const float* w_out = args.in[10]; const float* g_mlp = args.in[11]; const float* w_up = args.in[12]; const float* w_down = args.in[13]; const float* g_fin = args.in[14];
    float* out = args.out;
    bf16* WCAT = (bf16*)(ws + WS_WCAT); bf16* WATT = (bf16*)(ws + WS_WATT); bf16* WMLS = (bf16*)(ws + WS_WMLS); bf16* WOUT = (bf16*)(ws + WS_WOUT);
    bf16* WUP = (bf16*)(ws + WS_WUP); bf16* WDOWN = (bf16*)(ws + WS_WDOWN); bf16* XN = (bf16*)(ws + WS_XN);
    unsigned char* XNQ = ws + WS_XN8; unsigned char* WQ = ws + WS_WCAT;
    unsigned char* ATTQ = ws + WS_ATT; unsigned char* MLSQ = ws + WS_MLS; unsigned char* MERGEDQ = ws + WS_MLS;
    float* SAA = (float*)(ws + WS_CTL) + CW_SAA; float* SAM = (float*)(ws + WS_CTL) + CW_SAM; float* SAG = (float*)(ws + WS_CTL) + CW_SAG;
    float* XR = (float*)(ws + WS_CTL) + CW_XR;
    float* SA = (float*)(ws + WS_CTL) + CW_SA; unsigned* CMAX = (unsigned*)(ws + WS_CTL) + CW_CMAX; float* SB = (float*)(ws + WS_CTL) + CW_SB;
    bf16* QKV = (bf16*)(ws + WS_QKV); bf16* MQ = (bf16*)(ws + WS_MQ); bf16* MK = (bf16*)(ws + WS_MK); bf16* MV = (bf16*)(ws + WS_MV); bf16* MO = (bf16*)(ws + WS_MO);
    float* IFG = (float*)(ws + WS_IFG); float* LSE = (float*)(ws + WS_LSE); bf16* GATES = (bf16*)out;
    bf16* AO = (bf16*)(ws + WS_AO); bf16* HRAW = (bf16*)(ws + WS_HRAW); bf16* ATT = (bf16*)(ws + WS_ATT); bf16* MLS = (bf16*)(ws + WS_MLS);
    bf16* T1 = (bf16*)(ws + WS_T1); float* SS1 = (float*)(ws + WS_CTL) + CW_SS1; float* SS2 = SS1 + M; bf16* MERGED = (bf16*)(ws + WS_MERGED); bf16* HG = (bf16*)(ws + WS_HG); bf16* U = (bf16*)(ws + WS_U);

    for (int u = F.tid; u < (LDS_BYTES - LDSCTL_OFF) / 4; u += NWAVES * 64) ((LAS unsigned*)(F.lds + LDSCTL_OFF))[u] = 0u;
    __syncthreads();
    XcdBarrier bar; bar.bar = (unsigned*)(ctl + CW_BAR); bar.x = 0; bar.st = nullptr;
    if (N_LAUNCHES != PER_PHASE) bar = xcd_barrier_post((unsigned*)(ctl + CW_BAR), MISC + 8);
#define GRID_BAR(seam) do { if (N_LAUNCHES == PER_PHASE) { if (F.tid == 0) __hip_atomic_store(ctl + CW_TMO, 0xBADBA0u | (unsigned)(seam), RLX_AGENT); } else { xcd_barrier(bar); } } while (0)
    const int lo = args.ph_lo, hi = args.ph_hi;
#if defined(MK_LAST_PHASE)
    if (lo > MK_LAST_PHASE) return;
#endif
#define IN(k) (lo <= (k) && (k) < hi)
#define BOTH(k) (IN(k) && IN((k) + 1))

    if (IN(0)) { const P0Args A{x, g_mix, w_in, w_attn, w_mlstm, w_gate, w_out, WCAT, WATT, WMLS, WOUT, XN, SS1, XNQ, WQ, SA, CMAX, SB, XR};
        p0_pass_a(F, A); GRID_BAR(0); p0_prologue(F, A);
#if MK_DUP == 0
        GRID_BAR(0); p0_prologue(F, A);
#endif
        if (BOTH(0)) GRID_BAR(0); }
    if (IN(1)) {
        pg8::Gemm g{(const pg8::bf16_t*)XNQ, (const pg8::bf16_t*)WQ, M, NCAT - 256 - 4096, D / 2, SA, SB}; pg8::StaticOrder S; S.init(M, NCAT - 256 - 4096, F.G, F.bx, 8, 36, 16);
        pg8::EpiInProj E{QKV, ws, GATES, b_gate, 0, 1.0f};
        {
          pg8::Gemm gb{XN, WCAT + (size_t)14848 * D, M, 4096, D}; pg8::StaticOrder Sb; Sb.init(M, 4096, F.G, F.bx); pg8::EpiInProj Eb{QKV, ws, GATES, b_gate, 36, 1.0f};
          pg8::gemm_phase<pg8::EpiInProj, pg8::StaticOrder, PG8_ALIGN, PG8_SP2>(F.lds + RING_OFF, gb, Sb, Eb); }
        static_assert(pg8::EpiInProj::MQ_OFF == WS_MQ && pg8::EpiInProj::MK_OFF == WS_MK && pg8::EpiInProj::MV_OFF == WS_MV && pg8::EpiInProj::MO_OFF == WS_MO, "epilogue offsets vs ws map");
        pg8::gemm_phase<pg8::EpiInProj, pg8::StaticOrder, PG8_ALIGN, PG8_SP2, 2>(F.lds + RING_OFF, g, S, E);
        { Ctx F2 = F; asm volatile("" : "+v"(F2.lane), "+v"(F2.tid));
          p1_if_gates(F2, XN, WCAT + (size_t)(NCAT - 256) * D, IFG); }
        if (BOTH(1)) GRID_BAR(1);
    }
    if (IN(2)) {
        if (F.G >= 2) {
            const int half = F.G >> 1, odd_n = F.G - half;
            if ((F.bx & 1) == 0 && (F.bx >> 1) < half) { mlstm_fast(F, MQ, MK, MV, IFG, b_ig, b_fg, HRAW, F.bx >> 1, half);
#if MK_DUP == 21
                __syncthreads(); mlstm_fast(F, MQ, MK, MV, IFG, b_ig, b_fg, HRAW, F.bx >> 1, half);
#endif
            } else { attn_fast(F, QKV, AO, LSE, w_up, w_down, WUP, WDOWN, g_mlp, (F.bx & 1) ? (F.bx >> 1) : (odd_n - 1), odd_n);
#if MK_DUP == 20
                attn_fast(F, QKV, AO, LSE, w_up, w_down, WUP, WDOWN, g_mlp, (F.bx & 1) ? (F.bx >> 1) : (odd_n - 1), odd_n);
#endif
            }
        } else { attn_fast(F, QKV, AO, LSE, w_up, w_down, WUP, WDOWN, g_mlp, 0, 1); __syncthreads(); mlstm_fast(F, MQ, MK, MV, IFG, b_ig, b_fg, HRAW, 0, 1); }
        if (BOTH(2)) GRID_BAR(2);
    }
    if (IN(3)) { const P3Args A{AO, LSE, HRAW, MO, g_mls, ATTQ, MLSQ, SAA, SAM}; p3_mix(F, A);
#if MK_DUP == 3
        GRID_BAR(3); p3_mix(F, A);
#endif
        if (BOTH(3)) GRID_BAR(3); }
    if (IN(4)) {
        const pg8::Gemm ga{(const pg8::bf16_t*)ATTQ, (const pg8::bf16_t*)WATT, M, D, 512, SAA, SB + 29696};
        const pg8::Gemm gm{(const pg8::bf16_t*)MLSQ, (const pg8::bf16_t*)WMLS, M, D, 2048, SAM, SB + 33792};
        pg8::StaticOrder S; S.init(M, D, F.G, F.bx);
        if ((F.bx & 1) == 0) {
        { pg8::EpiBranchA E{T1}; pg8::gemm_phase<pg8::EpiBranchA, pg8::StaticOrder, PG8_ALIGN, PG8_SP2, 2>(F.lds + RING_OFF, ga, S, E); }
        VM_WAIT();
        { pg8::EpiBranchM E{T1, GATES, MERGED}; pg8::gemm_phase<pg8::EpiBranchM, pg8::StaticOrder, PG8_ALIGN, PG8_SP2, 2>(F.lds + RING_OFF, gm, S, E); }
        } else {
        { pg8::EpiBranchM1 E{T1, GATES}; pg8::gemm_phase<pg8::EpiBranchM1, pg8::StaticOrder, PG8_ALIGN, PG8_SP2, 2>(F.lds + RING_OFF, gm, S, E); }
        VM_WAIT();
        { pg8::EpiBranchA2 E{T1, GATES, MERGED}; pg8::gemm_phase<pg8::EpiBranchA2, pg8::StaticOrder, PG8_ALIGN, PG8_SP2, 2>(F.lds + RING_OFF, ga, S, E); }
        }
        GRID_BAR(4);
        p45_quant_rows(F, MERGED, MERGEDQ, SAG);
        if (BOTH(4)) GRID_BAR(4);
    }
    if (IN(5)) {
        pg8::Gemm g{(const pg8::bf16_t*)MERGEDQ, (const pg8::bf16_t*)WOUT, M, D, 2048, SAG, SB + 37888}; pg8::StaticOrder S; S.init(M, D, F.G, F.bx); pg8::EpiOutProj E{XN, XR, g_mix, HG, SS1};
        pg8::gemm_phase<pg8::EpiOutProj, pg8::StaticOrder, PG8_ALIGN, PG8_SP2, 2>(F.lds + RING_OFF, g, S, E);
        if (BOTH(5)) GRID_BAR(5);
    }
    if (IN(7)) {
        pg8::Gemm g{HG, WUP, M, FF, D}; pg8::StaticOrder S; S.init(M, FF, F.G, F.bx); pg8::EpiUp E{U, SS1};
        pg8::gemm_phase<pg8::EpiUp, pg8::StaticOrder, PG8_ALIGN, PG8_SP2>(F.lds + RING_OFF, g, S, E);
#if MK_DUP == 7
        GRID_BAR(7); pg8::gemm_phase<pg8::EpiUp, pg8::StaticOrder, PG8_ALIGN, PG8_SP2>(F.lds + RING_OFF, g, S, E);
#endif
        if (BOTH(7)) GRID_BAR(7);
    }
    if (IN(8)) {
        pg8::Gemm g{U, WDOWN, M, D, FF}; pg8::StaticOrder S; S.init(M, D, F.G, F.bx, 4); pg8::EpiDown E{HG, SS2};
        pg8::gemm_phase<pg8::EpiDown, pg8::StaticOrder, PG8_ALIGN, PG8_SP2>(F.lds + RING_OFF, g, S, E);
        if (BOTH(8)) GRID_BAR(8);
    }
    if (IN(9)) p9_final(F, HG, SS2, g_fin, out);
#undef IN
#undef BOTH
}

extern "C" void kernel_launch(void* const* d_in, const int* in_sizes, int n_in, void* d_out, int out_size, void* d_ws, size_t ws_size, hipStream_t stream) {
    static int grid = 0;
    if (grid == 0) {
        if (n_in != 15 || in_sizes[0] != M * D || out_size != M * D || ws_size < WS_END) { fprintf(stderr, "kernel_launch: unexpected shapes (n_in %d, in0 %d, out %d, ws %zu < %zu); nothing launched\n", n_in, n_in > 0 ? in_sizes[0] : -1, out_size, ws_size, (size_t)WS_END); grid = -1; return; }
        int dev = 0, cus = 0, per_cu = 0;
        if (hipGetDevice(&dev) != hipSuccess || hipDeviceGetAttribute(&cus, hipDeviceAttributeMultiprocessorCount, dev) != hipSuccess) { grid = -1; return; }
        if (hipFuncSetAttribute((const void*)hybrid_fwd, hipFuncAttributeMaxDynamicSharedMemorySize, LDS_BYTES) != hipSuccess) { fprintf(stderr, "kernel_launch: hipFuncSetAttribute failed\n"); grid = -1; return; }
        if (hipOccupancyMaxActiveBlocksPerMultiprocessor(&per_cu, (const void*)hybrid_fwd, NWAVES * 64, LDS_BYTES) != hipSuccess || per_cu < 1)
            fprintf(stderr, "kernel_launch: note: occupancy query reports %d workgroups per CU\n", per_cu);
        (void)hipGetLastError();
        grid = cus;
    }
    if (grid < 0) return;
    if (N_LAUNCHES != PER_PHASE) { if (hipMemsetAsync((char*)d_ws + WS_CTL, 0, CTL_ZERO_BYTES, stream) != hipSuccess) return; }
    Args a{};
    for (int i = 0; i < 15; ++i) a.in[i] = (const float*)d_in[i];
    a.out = (float*)d_out; a.ws = (unsigned char*)d_ws;
    for (int li = 0; li < N_LAUNCHES; ++li) {
        a.ph_lo = (N_LAUNCHES == PER_PHASE) ? li : 0; a.ph_hi = (N_LAUNCHES == PER_PHASE) ? li + 1 : PER_PHASE; a.li = li;
        hipLaunchKernelGGL(hybrid_fwd, dim3(grid), dim3(NWAVES * 64), LDS_BYTES, stream, a);
        const hipError_t le = hipPeekAtLastError();
        if (le != hipSuccess) { fprintf(stderr, "kernel_launch: launch %d failed: %s\n", li, hipGetErrorName(le)); break; }
    }
}
```

```cpp
#include <hip/hip_runtime.h>
#include <cstdio>
#include <cstdint>
#define PG8_NA8 32

namespace pg8 {
#define PG8_LAS __attribute__((address_space(3)))
typedef unsigned short bf16_t;
typedef short bf16x8 __attribute__((ext_vector_type(8)));
typedef int i32x4v __attribute__((ext_vector_type(4)));
typedef int i32x8v __attribute__((ext_vector_type(8)));
__device__ __forceinline__ i32x8v cat8(const bf16x8& a, const bf16x8& b) { return __builtin_shufflevector(__builtin_bit_cast(i32x4v, a), __builtin_bit_cast(i32x4v, b), 0, 1, 2, 3, 4, 5, 6, 7); }
typedef float f32x4 __attribute__((ext_vector_type(4)));
typedef unsigned u32x4 __attribute__((ext_vector_type(4)));
constexpr int BM = 256, BK = 64, HALF = 128, HTB = HALF * BK * 2  , STAGE_BYTES = 8 * HTB, NXCD = 8, WGM = 8;

__host__ __device__ __forceinline__ int lds_byte(int r, int c) { const int st = (r >> 4) * 2 + (c >> 5), rr = r & 15, cc = c & 31, ob = rr * 64 + cc * 2; return st * 1024 + (ob ^ (((ob >> 9) & 1) << 5)); }
__host__ __device__ __forceinline__ void stage_rc(int b, int& R, int& C) { const int st = b / 1024, sb = b % 1024, swz = sb ^ (((sb >> 9) & 1) << 5); R = (st >> 1) * 16 + swz / 64; C = (st & 1) * 32 + (swz % 64) / 2; }
__host__ __device__ __forceinline__ int perm32(int rho) { const int n = rho >> 4, i = rho & 15; return 8 * (i >> 2) + 4 * n + (i & 3); }

struct Unit { int pm, pn; };
struct Gemm { const bf16_t* A; const bf16_t* Bt; int M, N, K; const float* sa = nullptr; const float* sb = nullptr; };

struct StaticOrder {
    int nM, nN, nwg, G, c, wgm, skip_lo, skip_n;
    __host__ __device__ void init(int M, int N, int G_, int c_, int wgm_ = WGM, int skip_lo_ = 1 << 30, int skip_n_ = 0) { nM = M / BM; nN = N / BM; nwg = nM * nN; G = G_; c = c_; wgm = wgm_; skip_lo = skip_lo_; skip_n = skip_n_; }
    __host__ __device__ bool next(int i, Unit& u) const {
        const long L = (long)i * G + c; if (L >= nwg) return false;
        int wgid = (int)L; { const int q = nwg / NXCD, r = nwg % NXCD, xcd = wgid % NXCD, off = wgid / NXCD; wgid = (xcd < r ? xcd * (q + 1) : r * (q + 1) + (xcd - r) * q) + off; }
        const int nig = wgm * nN, gid = wgid / nig, fm = gid * wgm, gsz = (nM - fm) < wgm ? (nM - fm) : wgm;
        u.pm = fm + ((wgid % nig) % gsz); u.pn = (wgid % nig) / gsz; if (u.pn >= skip_lo) u.pn += skip_n; return true;
    }
    __device__ __forceinline__ void a_ready(const Unit&) const {}
    __device__ __forceinline__ void done(const Unit&) const {}
};
typedef __bf16 bf16x2_t __attribute__((ext_vector_type(2)));
typedef float f32x2 __attribute__((ext_vector_type(2)));
__device__ __forceinline__ unsigned cvt_pk_bf16(float lo, float hi) { const f32x2 f = {lo, hi}; return __builtin_bit_cast(unsigned, __builtin_convertvector(f, bf16x2_t)); }
__device__ __forceinline__ float bf_lo(unsigned w) { return __uint_as_float(w << 16); }
__device__ __forceinline__ float bf_hi(unsigned w) { return __uint_as_float(w & 0xffff0000u); }
__device__ __forceinline__ u32x4 pack8(const f32x4& a, const f32x4& b) { u32x4 w; w.x = cvt_pk_bf16(a[0], a[1]); w.y = cvt_pk_bf16(a[2], a[3]); w.z = cvt_pk_bf16(b[0], b[1]); w.w = cvt_pk_bf16(b[2], b[3]); return w; }
__device__ __forceinline__ float sigmoid_f(float x) { return __builtin_amdgcn_rcpf(1.0f + __expf(-x)); }
typedef unsigned u32x2 __attribute__((ext_vector_type(2)));
__device__ __forceinline__ unsigned gate_q(float g) { return (unsigned)__builtin_rintf(g * 255.0f); }
__device__ __forceinline__ u32x2 gate_pack8(const f32x4& a, const f32x4& b) {
    u32x2 w; w.x = gate_q(a[0]) | (gate_q(a[1]) << 8) | (gate_q(a[2]) << 16) | (gate_q(a[3]) << 24); w.y = gate_q(b[0]) | (gate_q(b[1]) << 8) | (gate_q(b[2]) << 16) | (gate_q(b[3]) << 24); return w;
}
__device__ __forceinline__ u32x2 gate_ld(const bf16_t* GATES, size_t row, int col) { return *(const u32x2*)((const unsigned char*)GATES + row * 8192 + col); }
__device__ __forceinline__ f32x4 gate_lo(const u32x2& g) { return (f32x4){(float)(g.x & 255u), (float)((g.x >> 8) & 255u), (float)((g.x >> 16) & 255u), (float)(g.x >> 24)} * (1.0f / 255.0f); }
__device__ __forceinline__ f32x4 gate_hi(const u32x2& g) { return (f32x4){(float)(g.y & 255u), (float)((g.y >> 8) & 255u), (float)((g.y >> 16) & 255u), (float)(g.y >> 24)} * (1.0f / 255.0f); }
__device__ __forceinline__ u32x4* t1_slot(const bf16_t* T1, const Unit& u, int ai, int m, int bj) {
    return (u32x4*)T1 + ((size_t)((u.pm * 16 + u.pn) * 16 + (ai * 4 + m) * 2 + bj) * 512 + threadIdx.x);
}
constexpr int EM = 16384;
constexpr size_t ATT_T = (size_t)EM * 3072, ATT_G = (size_t)EM * 1024;

struct EpiInProj {
    static constexpr bool PERM = true, AFTER_DRAIN = false;
    bf16_t* QKV; unsigned char* WSB; bf16_t* GATES; const float* b_gate; int pn_off; float osc;
    static constexpr size_t MQ_OFF = (size_t)730 << 20, MK_OFF = (size_t)794 << 20, MV_OFF = (size_t)858 << 20, MO_OFF = (size_t)986 << 20;
    __device__ __forceinline__ void operator()(const f32x4 (&acc)[2][2][4][2], const Unit& u, int wr, int wc, int fr, int fq) const {
        const int pn = u.pn + pn_off, row0 = u.pm * BM + wr * 64 + fr, cl = wc * 32 + 8 * fq;
        if (pn < 36) {
            const int which = pn / 12, rem = pn - which * 12, g = rem >> 2, hp = rem & 3, sh = 2 * g;
            bf16_t* base = QKV + (size_t)which * ATT_T + (size_t)g * ATT_G + cl;
#pragma unroll
            for (int ai = 0; ai < 2; ++ai)
#pragma unroll
                for (int m = 0; m < 4; ++m) {
                    const int row = row0 + ai * HALF + m * 16, b = row >> 13, t = row & 8191, r = t & ((1 << sh) - 1), j = t >> sh;
                    const size_t ro = ((size_t)(b * 8) << 13) + (size_t)r * (size_t)(8192 >> sh) + (size_t)j;
#pragma unroll
                    for (int bj = 0; bj < 2; ++bj) { const int h = hp * 2 + bj;
                        *(u32x4*)(base + ((ro + ((size_t)h << 13)) << 7)) = pack8(acc[ai][bj][m][0] * osc, acc[ai][bj][m][1] * osc); }
                }
        } else if (pn >= 68 && pn < 84) {
            unsigned char* base = WSB + MO_OFF; const int colt = (pn - 68) * 256;
#pragma unroll
            for (int ai = 0; ai < 2; ++ai)
#pragma unroll
                for (int m = 0; m < 4; ++m) { unsigned char* rowp = base + (size_t)(row0 + ai * HALF + m * 16) * 4096 + colt + cl;
#pragma unroll
                    for (int bj = 0; bj < 2; ++bj) { f32x4 v0 = acc[ai][bj][m][0], v1 = acc[ai][bj][m][1];
#pragma unroll
                        for (int q = 0; q < 4; ++q) { v0[q] = sigmoid_f(v0[q]); v1[q] = sigmoid_f(v1[q]); }
                        *(u32x2*)(rowp + bj * HALF) = gate_pack8(v0, v1); } }
        } else if (pn < 84) {
            const size_t off = pn < 44 ? MQ_OFF : pn < 52 ? MK_OFF : pn < 68 ? MV_OFF : MO_OFF;
            const int ld = pn < 52 ? 2048 : 4096, colt = (pn < 44 ? pn - 36 : pn < 52 ? pn - 44 : pn < 68 ? pn - 52 : pn - 68) * 256;
            const float sc = (pn >= 44 && pn < 52) ? 0.0625f : 1.0f;
            bf16_t* base = (bf16_t*)(WSB + off);
#pragma unroll
            for (int ai = 0; ai < 2; ++ai)
#pragma unroll
                for (int m = 0; m < 4; ++m) { bf16_t* rowp = base + (size_t)(row0 + ai * HALF + m * 16) * ld + colt + cl;
#pragma unroll
                    for (int bj = 0; bj < 2; ++bj) *(u32x4*)(rowp + bj * HALF) = pack8(acc[ai][bj][m][0] * sc, acc[ai][bj][m][1] * sc); }
        } else {
            const int colt = (pn - 84) * 256;
            f32x4 bv[2][2];
#pragma unroll
            for (int bj = 0; bj < 2; ++bj)
#pragma unroll
                for (int n = 0; n < 2; ++n) bv[bj][n] = *(const f32x4*)(b_gate + colt + bj * HALF + cl + 4 * n);
#pragma unroll
            for (int ai = 0; ai < 2; ++ai)
#pragma unroll
                for (int m = 0; m < 4; ++m) { unsigned char* rowp = (unsigned char*)GATES + (size_t)(row0 + ai * HALF + m * 16) * 8192 + colt + cl;
#pragma unroll
                    for (int bj = 0; bj < 2; ++bj) { f32x4 v0 = acc[ai][bj][m][0] + bv[bj][0], v1 = acc[ai][bj][m][1] + bv[bj][1];
#pragma unroll
                        for (int q = 0; q < 4; ++q) { v0[q] = sigmoid_f(v0[q]); v1[q] = sigmoid_f(v1[q]); }
                        *(u32x2*)(rowp + bj * HALF) = gate_pack8(v0, v1); } }
        }
    }
};
struct EpiGates8 {
    static constexpr bool PERM = true, AFTER_DRAIN = false;
    static constexpr int NA8 = PG8_NA8;
    bf16_t* GATES; const float* b_gate; bf16_t* MO; bf16_t* QKV;
    __device__ __forceinline__ void operator()(const f32x4 (&acc)[2][2][4][2], const Unit& u, int wr, int wc, int fr, int fq) const {
        const int row0 = u.pm * BM + wr * 64 + fr, cl = wc * 32 + 8 * fq;
        if (u.pn < NA8) { const EpiInProj A{QKV, nullptr, nullptr, nullptr, 0, 0.015625f}; A(acc, u, wr, wc, fr, fq); return; }
        if (u.pn < NA8 + 16) {
#pragma unroll
            for (int ai = 0; ai < 2; ++ai)
#pragma unroll
                for (int m = 0; m < 4; ++m) { bf16_t* rowp = MO + (size_t)(row0 + ai * HALF + m * 16) * 4096 + (u.pn - NA8) * 256 + cl;
#pragma unroll
                    for (int bj = 0; bj < 2; ++bj) *(u32x4*)(rowp + bj * HALF) = pack8(acc[ai][bj][m][0] * 0.015625f, acc[ai][bj][m][1] * 0.015625f); }
            return;
        }
        const int colt = (u.pn - NA8 - 16) * 256;
        f32x4 bv[2][2];
#pragma unroll
        for (int bj = 0; bj < 2; ++bj)
#pragma unroll
            for (int n = 0; n < 2; ++n) bv[bj][n] = *(const f32x4*)(b_gate + colt + bj * HALF + cl + 4 * n);
#pragma unroll
        for (int ai = 0; ai < 2; ++ai)
#pragma unroll
            for (int m = 0; m < 4; ++m) { bf16_t* rowp = GATES + (size_t)(row0 + ai * HALF + m * 16) * 8192 + colt + cl;
#pragma unroll
                for (int bj = 0; bj < 2; ++bj) { f32x4 v0 = acc[ai][bj][m][0] * 0.015625f + bv[bj][0], v1 = acc[ai][bj][m][1] * 0.015625f + bv[bj][1];
#pragma unroll
                    for (int q = 0; q < 4; ++q) { v0[q] = sigmoid_f(v0[q]); v1[q] = sigmoid_f(v1[q]); }
                    *(u32x4*)(rowp + bj * HALF) = pack8(v0, v1); } }
    }
};
struct EpiBranchA {
    static constexpr bool PERM = true, AFTER_DRAIN = false;
    bf16_t* T1;
    __device__ __forceinline__ void operator()(const f32x4 (&acc)[2][2][4][2], const Unit& u, int wr, int wc, int fr, int fq) const {
        const int row0 = u.pm * BM + wr * 64 + fr, col0 = u.pn * BM + wc * 32 + 8 * fq;
#pragma unroll
        for (int ai = 0; ai < 2; ++ai)
#pragma unroll
            for (int m = 0; m < 4; ++m) {
#pragma unroll
                for (int bj = 0; bj < 2; ++bj) *t1_slot(T1, u, ai, m, bj) = pack8(acc[ai][bj][m][0], acc[ai][bj][m][1]); }
    }
};
struct EpiBranchM {
    static constexpr bool PERM = true, AFTER_DRAIN = false;
    const bf16_t* T1; const bf16_t* GATES; bf16_t* MERGED;
    __device__ __forceinline__ void operator()(const f32x4 (&acc)[2][2][4][2], const Unit& u, int wr, int wc, int fr, int fq) const {
        const int row0 = u.pm * BM + wr * 64 + fr, col0 = u.pn * BM + wc * 32 + 8 * fq;
#pragma unroll
        for (int ai = 0; ai < 2; ++ai)
#pragma unroll
            for (int mp = 0; mp < 2; ++mp) {
                u32x2 ga[2][2], gm[2][2]; u32x4 tw[2][2];
#pragma unroll
                for (int mm = 0; mm < 2; ++mm)
#pragma unroll
                    for (int bj = 0; bj < 2; ++bj) { const size_t row = (size_t)(row0 + ai * HALF + (2 * mp + mm) * 16);
                        ga[mm][bj] = gate_ld(GATES, row, col0 + bj * HALF); gm[mm][bj] = gate_ld(GATES, row, 4096 + col0 + bj * HALF);
                        tw[mm][bj] = *t1_slot(T1, u, ai, 2 * mp + mm, bj); }
#pragma unroll
                for (int mm = 0; mm < 2; ++mm) { const int m = 2 * mp + mm; const size_t row = (size_t)(row0 + ai * HALF + m * 16);
#pragma unroll
                    for (int bj = 0; bj < 2; ++bj) { const u32x4 t = tw[mm][bj]; const f32x4 a0 = gate_lo(ga[mm][bj]), a1 = gate_hi(ga[mm][bj]), g0 = gate_lo(gm[mm][bj]), g1 = gate_hi(gm[mm][bj]);
                        f32x4 v0 = acc[ai][bj][m][0], v1 = acc[ai][bj][m][1];
                        v0 = (f32x4){bf_lo(t.x), bf_hi(t.x), bf_lo(t.y), bf_hi(t.y)} * a0 + v0 * g0;
                        v1 = (f32x4){bf_lo(t.z), bf_hi(t.z), bf_lo(t.w), bf_hi(t.w)} * a1 + v1 * g1;
                        *(u32x4*)(MERGED + row * 4096 + col0 + bj * HALF) = pack8(v0, v1); } }
            }
    }
};
struct EpiBranchM1 {
    static constexpr bool PERM = true, AFTER_DRAIN = false;
    bf16_t* T1; const bf16_t* GATES;
    __device__ __forceinline__ void operator()(const f32x4 (&acc)[2][2][4][2], const Unit& u, int wr, int wc, int fr, int fq) const {
        const int row0 = u.pm * BM + wr * 64 + fr, col0 = u.pn * BM + wc * 32 + 8 * fq;
#pragma unroll
        for (int ai = 0; ai < 2; ++ai) {
            u32x2 gm[4][2];
#pragma unroll
            for (int m = 0; m < 4; ++m)
#pragma unroll
                for (int bj = 0; bj < 2; ++bj) gm[m][bj] = gate_ld(GATES, (size_t)(row0 + ai * HALF + m * 16), 4096 + col0 + bj * HALF);
#pragma unroll
            for (int m = 0; m < 4; ++m) { const size_t row = (size_t)(row0 + ai * HALF + m * 16);
#pragma unroll
                for (int bj = 0; bj < 2; ++bj) { f32x4 v0 = acc[ai][bj][m][0] * gate_lo(gm[m][bj]), v1 = acc[ai][bj][m][1] * gate_hi(gm[m][bj]);
                    *t1_slot(T1, u, ai, m, bj) = pack8(v0, v1); } }
        }
    }
};
struct EpiBranchA2 {
    static constexpr bool PERM = true, AFTER_DRAIN = false;
    const bf16_t* T1; const bf16_t* GATES; bf16_t* MERGED;
    __device__ __forceinline__ void operator()(const f32x4 (&acc)[2][2][4][2], const Unit& u, int wr, int wc, int fr, int fq) const {
        const int row0 = u.pm * BM + wr * 64 + fr, col0 = u.pn * BM + wc * 32 + 8 * fq;
#pragma unroll
        for (int ai = 0; ai < 2; ++ai) {
            u32x2 ga[4][2]; u32x4 tw[4][2];
#pragma unroll
            for (int m = 0; m < 4; ++m)
#pragma unroll
                for (int bj = 0; bj < 2; ++bj) { const size_t row = (size_t)(row0 + ai * HALF + m * 16);
                    ga[m][bj] = gate_ld(GATES, row, col0 + bj * HALF); tw[m][bj] = *t1_slot(T1, u, ai, m, bj); }
#pragma unroll
            for (int m = 0; m < 4; ++m) { const size_t row = (size_t)(row0 + ai * HALF + m * 16);
#pragma unroll
                for (int bj = 0; bj < 2; ++bj) { const u32x4 t = tw[m][bj]; f32x4 v0 = acc[ai][bj][m][0], v1 = acc[ai][bj][m][1];
                    v0 = (f32x4){bf_lo(t.x), bf_hi(t.x), bf_lo(t.y), bf_hi(t.y)} + v0 * gate_lo(ga[m][bj]);
                    v1 = (f32x4){bf_lo(t.z), bf_hi(t.z), bf_lo(t.w), bf_hi(t.w)} + v1 * gate_hi(ga[m][bj]);
                    *(u32x4*)(MERGED + row * 4096 + col0 + bj * HALF) = pack8(v0, v1); } }
        }
    }
};
__device__ __forceinline__ void add_row_sumsq(float* ss, const float (&s)[4], int fq) {
    float r[4];
#pragma unroll
    for (int m = 0; m < 4; ++m) { float v = s[m]; v += __shfl_xor(v, 16); v += __shfl_xor(v, 32); r[m] = v; }
    const float mine = fq == 0 ? r[0] : fq == 1 ? r[1] : fq == 2 ? r[2] : r[3];
    atomicAdd(ss + (threadIdx.x & 63), mine);
}
struct EpiOutProj {
    static constexpr bool PERM = true, AFTER_DRAIN = false;
    const bf16_t* XN; const float* XR; const float* GMIX; bf16_t* H1; float* SS;
    __device__ __forceinline__ void operator()(const f32x4 (&acc)[2][2][4][2], const Unit& u, int wr, int wc, int fr, int fq) const {
        int fr_ = fr, fq_ = fq; asm volatile("" : "+v"(fr_), "+v"(fq_));
        const int row0 = u.pm * BM + wr * 64 + fr_, col0 = u.pn * BM + wc * 32 + 8 * fq_;
        f32x4 ig[2][2];
#pragma unroll
        for (int bj = 0; bj < 2; ++bj)
#pragma unroll
            for (int hh = 0; hh < 2; ++hh) { const f32x4 g = *(const f32x4*)(GMIX + col0 + bj * HALF + 4 * hh); ig[bj][hh] = (f32x4){1.0f / g[0], 1.0f / g[1], 1.0f / g[2], 1.0f / g[3]}; }
#pragma unroll
        for (int ai = 0; ai < 2; ++ai) { float s[4];
            u32x4 xw[4][2]; float xr[4];
#pragma unroll
            for (int m = 0; m < 4; ++m) { xr[m] = XR[row0 + ai * HALF + m * 16];
#pragma unroll
                for (int bj = 0; bj < 2; ++bj) xw[m][bj] = *(const u32x4*)(XN + (size_t)(row0 + ai * HALF + m * 16) * 4096 + col0 + bj * HALF); }
#pragma unroll
            for (int m = 0; m < 4; ++m) { const size_t row = (size_t)(row0 + ai * HALF + m * 16); float sq = 0.f;
#pragma unroll
                for (int bj = 0; bj < 2; ++bj) { const size_t off = row * 4096 + col0 + bj * HALF; const u32x4 t = xw[m][bj];
                    const f32x4 h0 = (f32x4){bf_lo(t.x), bf_hi(t.x), bf_lo(t.y), bf_hi(t.y)} * xr[m] * ig[bj][0] + acc[ai][bj][m][0], h1 = (f32x4){bf_lo(t.z), bf_hi(t.z), bf_lo(t.w), bf_hi(t.w)} * xr[m] * ig[bj][1] + acc[ai][bj][m][1];
                    sq += (h0[0] * h0[0] + h0[1] * h0[1]) + (h0[2] * h0[2] + h0[3] * h0[3]) + (h1[0] * h1[0] + h1[1] * h1[1]) + (h1[2] * h1[2] + h1[3] * h1[3]);
                    *(u32x4*)(H1 + off) = pack8(h0, h1); }
                s[m] = sq; }
            add_row_sumsq(SS + u.pm * BM + ai * HALF + wr * 64, s, fq); }
    }
};
struct EpiUp {
    static constexpr bool PERM = true, AFTER_DRAIN = false;
    bf16_t* U; const float* SS;
    __device__ __forceinline__ void operator()(const f32x4 (&acc)[2][2][4][2], const Unit& u, int wr, int wc, int fr, int fq) const {
        const int row0 = u.pm * BM + wr * 64 + fr, col0 = u.pn * BM + wc * 32 + 8 * fq;
        float ssv[2][4];
#pragma unroll
        for (int ai = 0; ai < 2; ++ai)
#pragma unroll
            for (int m = 0; m < 4; ++m) ssv[ai][m] = SS[row0 + ai * HALF + m * 16];
#pragma unroll
        for (int ai = 0; ai < 2; ++ai)
#pragma unroll
            for (int m = 0; m < 4; ++m) { const size_t row = (size_t)(row0 + ai * HALF + m * 16);
                const float rstd = 1.0f / sqrtf(ssv[ai][m] * (1.0f / 4096.0f) + 1e-6f);
#pragma unroll
                for (int bj = 0; bj < 2; ++bj) { f32x4 v0 = acc[ai][bj][m][0] * rstd, v1 = acc[ai][bj][m][1] * rstd;
#pragma unroll
                    for (int q = 0; q < 4; ++q) { const float a = fmaxf(v0[q], 0.f), c = fmaxf(v1[q], 0.f); v0[q] = a * a; v1[q] = c * c; }
                    *(u32x4*)(U + row * 16384 + col0 + bj * HALF) = pack8(v0, v1); } }
    }
};
struct EpiDown {
    static constexpr bool PERM = true, AFTER_DRAIN = false;
    bf16_t* H; float* SS;
    __device__ __forceinline__ void operator()(const f32x4 (&acc)[2][2][4][2], const Unit& u, int wr, int wc, int fr, int fq) const {
        const int row0 = u.pm * BM + wr * 64 + fr, col0 = u.pn * BM + wc * 32 + 8 * fq;
#pragma unroll
        for (int ai = 0; ai < 2; ++ai) { float s[4];
            u32x4 hw[4][2];
#pragma unroll
            for (int m = 0; m < 4; ++m)
#pragma unroll
                for (int bj = 0; bj < 2; ++bj) hw[m][bj] = *(const u32x4*)(H + (size_t)(row0 + ai * HALF + m * 16) * 4096 + col0 + bj * HALF);
#pragma unroll
            for (int m = 0; m < 4; ++m) { float sq = 0.f;
#pragma unroll
                for (int bj = 0; bj < 2; ++bj) { const size_t off = (size_t)(row0 + ai * HALF + m * 16) * 4096 + col0 + bj * HALF; const u32x4 t = hw[m][bj];
                    f32x4 h0 = acc[ai][bj][m][0], h1 = acc[ai][bj][m][1];
                    h0[0] += bf_lo(t.x); h0[1] += bf_hi(t.x); h0[2] += bf_lo(t.y); h0[3] += bf_hi(t.y); h1[0] += bf_lo(t.z); h1[1] += bf_hi(t.z); h1[2] += bf_lo(t.w); h1[3] += bf_hi(t.w);
                    sq += (h0[0] * h0[0] + h0[1] * h0[1]) + (h0[2] * h0[2] + h0[3] * h0[3]) + (h1[0] * h1[0] + h1[1] * h1[1]) + (h1[2] * h1[2] + h1[3] * h1[3]);
                    *(u32x4*)(H + off) = pack8(h0, h1); }
                s[m] = sq; }
            add_row_sumsq(SS + u.pm * BM + ai * HALF + wr * 64, s, fq); }
    }
};

template <class Epi, class Sched, bool ALIGN_EPI = false, bool SP2 = false, int QM = 0>
__device__ __forceinline__ void gemm_phase(PG8_LAS unsigned char* lds, const Gemm g, const Sched& S, const Epi& E) {
    constexpr bool F8 = (QM == 1), I8 = (QM == 2);
    int tid_ = threadIdx.x; asm volatile("" : "+v"(tid_));
    const int tid = tid_, wid = __builtin_amdgcn_readfirstlane(tid >> 6), lane = tid & 63, wr = wid >> 2, wc = wid & 3, fr = lane & 15, fq = lane >> 4;
    const int K = g.K, nt = K / BK;
    unsigned voffA[2], voffB[2];
#pragma unroll
    for (int i = 0; i < 2; ++i) { int R, C; stage_rc(tid * 16 + i * 8192, R, C); const int Rb = Epi::PERM ? ((R & ~31) + perm32(R & 31)) : R;
        voffA[i] = (unsigned)(R * K + C) * 2u; voffB[i] = (unsigned)(Rb * K + C) * 2u; }
    const size_t kstep = (size_t)(BK * 2);
    const size_t hstep = (size_t)HALF * K * 2;
    const size_t tstep = 2 * hstep;
    const unsigned ldsw = (unsigned)wid * 1024u;
    const int aoff = lds_byte(wr * 64 + fr, fq * 8), boff = lds_byte(wc * 32 + fr, fq * 8);
#define PG8_SA(b, h) (((b) * 2 + (h)) * HTB)
#define PG8_SB(b, h) ((4 + (b) * 2 + (h)) * HTB)
#define PG8_STAGE(bufoff, gbase, voff) do { _Pragma("unroll") for (int _i = 0; _i < 2; ++_i) \
        __builtin_amdgcn_global_load_lds((const unsigned*)((const char*)(gbase) + (voff)[_i]), (PG8_LAS unsigned*)(lds + (bufoff) + ldsw + _i * 8192), 16, 0, 0); } while (0)
#define PG8_LD16(p) (*(const PG8_LAS i32x4v*)(p))
#define PG8_LDA(dst, b, h) do { if constexpr (F8) { _Pragma("unroll") for (int m = 0; m < 4; ++m) dst##8[m] = __builtin_shufflevector(PG8_LD16(lds + PG8_SA(b, h) + aoff + m * 2048), PG8_LD16(lds + PG8_SA(b, h) + aoff + m * 2048 + 1024), 0, 1, 2, 3, 4, 5, 6, 7); } \
        else { _Pragma("unroll") for (int m = 0; m < 4; ++m) _Pragma("unroll") for (int k = 0; k < 2; ++k) dst[m][k] = *(const PG8_LAS bf16x8*)(lds + PG8_SA(b, h) + aoff + m * 2048 + k * 1024); } } while (0)
#define PG8_LDB(dst, b, h) do { if constexpr (F8) { _Pragma("unroll") for (int n = 0; n < 2; ++n) dst##8[n] = __builtin_shufflevector(PG8_LD16(lds + PG8_SB(b, h) + boff + n * 2048), PG8_LD16(lds + PG8_SB(b, h) + boff + n * 2048 + 1024), 0, 1, 2, 3, 4, 5, 6, 7); } \
        else { _Pragma("unroll") for (int n = 0; n < 2; ++n) _Pragma("unroll") for (int k = 0; k < 2; ++k) dst[n][k] = *(const PG8_LAS bf16x8*)(lds + PG8_SB(b, h) + boff + n * 2048 + k * 1024); } } while (0)
#define PG8_MMA(ai, bj, At, Bt) do { __builtin_amdgcn_s_setprio(1); _Pragma("unroll") for (int m = 0; m < 4; ++m) _Pragma("unroll") for (int n = 0; n < 2; ++n) { \
        if constexpr (F8) asm volatile("v_mfma_scale_f32_16x16x128_f8f6f4 %0, %1, %2, %0, %3, %3 op_sel_hi:[0,0,0]" : "+v"(acc[ai][bj][m][n]) : "v"(Bt##8[n]), "v"(At##8[m]), "v"(f8scale)); \
        else if constexpr (I8) { _Pragma("unroll") for (int k = 0; k < 2; ++k) acc[ai][bj][m][n] = __builtin_bit_cast(f32x4, __builtin_amdgcn_mfma_i32_16x16x64_i8(__builtin_bit_cast(i32x4v, Bt[n][k]), __builtin_bit_cast(i32x4v, At[m][k]), __builtin_bit_cast(i32x4v, acc[ai][bj][m][n]), 0, 0, 0)); } \
        else { _Pragma("unroll") for (int k = 0; k < 2; ++k) acc[ai][bj][m][n] = __builtin_amdgcn_mfma_f32_16x16x32_bf16(Bt[n][k], At[m][k], acc[ai][bj][m][n], 0, 0, 0); } } \
        __builtin_amdgcn_s_setprio(0); } while (0)
#define PG8_WAIT_V(n) asm volatile("s_waitcnt vmcnt(" #n ")" ::: "memory")
#define PG8_WAIT_L(n) asm volatile("s_waitcnt lgkmcnt(" #n ")" ::: "memory")
#define PG8_BAR __builtin_amdgcn_s_barrier()
#define PG8_SCHED __builtin_amdgcn_sched_barrier(0)
    Unit cur, nxt; int ui = 0;
    if (!S.next(0, cur)) return;
    f32x4 acc[2][2][4][2];
#pragma unroll
    for (int a = 0; a < 2; ++a)
#pragma unroll
        for (int b = 0; b < 2; ++b)
#pragma unroll
            for (int m = 0; m < 4; ++m)
#pragma unroll
                for (int n = 0; n < 2; ++n) acc[a][b][m][n] = (f32x4){0.f, 0.f, 0.f, 0.f};
    bf16x8 At[4][2], B0[2][2], B1[2][2];
    const int f8scale = 0x7f7f7f7f;
    i32x8v At8[4], B08[2], B18[2];
    const char* cA = (const char*)g.A + (size_t)cur.pm * tstep; const char* cB = (const char*)g.Bt + (size_t)cur.pn * tstep;
    S.a_ready(cur);
    if constexpr (SP2) {
        PG8_STAGE(PG8_SB(0, 0), cB, voffB); PG8_STAGE(PG8_SB(0, 1), cB + hstep, voffB); PG8_STAGE(PG8_SA(0, 0), cA, voffA); PG8_STAGE(PG8_SA(0, 1), cA + hstep, voffA);
        if (wr == 1) PG8_BAR;
        PG8_WAIT_V(2); PG8_BAR;
        PG8_STAGE(PG8_SB(1, 0), cB + kstep, voffB); PG8_STAGE(PG8_SA(1, 0), cA + kstep, voffA); PG8_STAGE(PG8_SB(1, 1), cB + hstep + kstep, voffB);
        PG8_WAIT_V(6); PG8_BAR;
    } else {
        PG8_STAGE(PG8_SB(0, 0), cB, voffB); PG8_STAGE(PG8_SA(0, 0), cA, voffA); PG8_STAGE(PG8_SB(0, 1), cB + hstep, voffB); PG8_STAGE(PG8_SA(0, 1), cA + hstep, voffA);
        if (wr == 1) PG8_BAR;
        PG8_WAIT_V(4); PG8_BAR;
        PG8_STAGE(PG8_SB(1, 0), cB + kstep, voffB); PG8_STAGE(PG8_SA(1, 0), cA + kstep, voffA); PG8_STAGE(PG8_SB(1, 1), cB + hstep + kstep, voffB);
        PG8_WAIT_V(6); PG8_BAR;
    }
    for (;;) {
        const bool has_next = S.next(ui + 1, nxt);
        const char* nA = has_next ? (const char*)g.A + (size_t)nxt.pm * tstep : cA; const char* nB = has_next ? (const char*)g.Bt + (size_t)nxt.pn * tstep : cB;
        for (int t = 0; t < nt; t += 2) {
            const bool last = (t == nt - 2);
            const char* a1 = cA + (size_t)(t + 1) * kstep;
            const char* a2 = last ? nA : cA + (size_t)(t + 2) * kstep; const char* b2 = last ? nB : cB + (size_t)(t + 2) * kstep;
            const char* a3 = a2 + kstep; const char* b3 = b2 + kstep;
            if (last && has_next) S.a_ready(nxt);
            if constexpr (SP2) {
            PG8_LDB(B0, 0, 0); PG8_LDB(B1, 0, 1); PG8_SCHED; PG8_LDA(At, 0, 0); PG8_STAGE(PG8_SA(1, 1), a1 + hstep, voffA);
            PG8_WAIT_V(8); PG8_WAIT_L(0); PG8_BAR; PG8_MMA(0, 0, At, B0); PG8_MMA(0, 1, At, B1); PG8_BAR; PG8_SCHED;
            PG8_LDA(At, 0, 1); PG8_STAGE(PG8_SB(0, 0), b2, voffB); PG8_STAGE(PG8_SB(0, 1), b2 + hstep, voffB); PG8_STAGE(PG8_SA(0, 0), a2, voffA);
            PG8_WAIT_V(8); PG8_WAIT_L(0); PG8_BAR; PG8_MMA(1, 0, At, B0); PG8_MMA(1, 1, At, B1); PG8_BAR; PG8_SCHED;
            PG8_LDB(B0, 1, 0); PG8_LDB(B1, 1, 1); PG8_SCHED; PG8_LDA(At, 1, 0); PG8_STAGE(PG8_SA(0, 1), a2 + hstep, voffA);
            PG8_WAIT_V(8); PG8_WAIT_L(0); PG8_BAR; PG8_MMA(0, 0, At, B0); PG8_MMA(0, 1, At, B1); PG8_BAR; PG8_SCHED;
            PG8_LDA(At, 1, 1); PG8_STAGE(PG8_SB(1, 0), b3, voffB); PG8_STAGE(PG8_SB(1, 1), b3 + hstep, voffB); PG8_STAGE(PG8_SA(1, 0), a3, voffA);
            PG8_WAIT_V(8); PG8_WAIT_L(0); PG8_BAR; PG8_MMA(1, 0, At, B0); PG8_MMA(1, 1, At, B1); PG8_BAR; PG8_SCHED;
            } else {
            PG8_LDB(B0, 0, 0); PG8_SCHED; PG8_LDA(At, 0, 0); PG8_STAGE(PG8_SA(1, 1), a1 + hstep, voffA);
            PG8_WAIT_L(8); PG8_BAR; PG8_WAIT_L(0); PG8_MMA(0, 0, At, B0); PG8_BAR; PG8_SCHED;
            PG8_LDB(B1, 0, 1); PG8_STAGE(PG8_SB(0, 0), b2, voffB);
            PG8_BAR; PG8_WAIT_L(0); PG8_MMA(0, 1, At, B1); PG8_BAR;
            PG8_LDA(At, 0, 1); PG8_STAGE(PG8_SA(0, 0), a2, voffA);
            PG8_BAR; PG8_WAIT_L(0); PG8_MMA(1, 0, At, B0); PG8_BAR; PG8_SCHED;
            PG8_STAGE(PG8_SB(0, 1), b2 + hstep, voffB);
            PG8_WAIT_V(6); PG8_BAR; PG8_MMA(1, 1, At, B1); PG8_BAR;
            PG8_LDB(B0, 1, 0); PG8_SCHED; PG8_LDA(At, 1, 0); PG8_STAGE(PG8_SA(0, 1), a2 + hstep, voffA);
            PG8_WAIT_L(8); PG8_BAR; PG8_WAIT_L(0); PG8_MMA(0, 0, At, B0); PG8_BAR; PG8_SCHED;
            PG8_LDB(B1, 1, 1); PG8_STAGE(PG8_SB(1, 0), b3, voffB);
            PG8_BAR; PG8_WAIT_L(0); PG8_MMA(0, 1, At, B1); PG8_BAR;
            PG8_LDA(At, 1, 1); PG8_STAGE(PG8_SA(1, 0), a3, voffA);
            PG8_BAR; PG8_WAIT_L(0); PG8_MMA(1, 0, At, B0); PG8_BAR; PG8_SCHED;
            PG8_STAGE(PG8_SB(1, 1), b3 + hstep, voffB);
            PG8_WAIT_V(6); PG8_BAR; PG8_MMA(1, 1, At, B1); PG8_BAR;
            }
        }
        int fr2 = fr, fq2 = fq;
        if constexpr (I8) {
            __builtin_amdgcn_sched_barrier(0);
            asm volatile("" : "+v"(fr2), "+v"(fq2));
#pragma unroll
            for (int ai = 0; ai < 2; ++ai) {
                float sr[4];
#pragma unroll
                for (int m = 0; m < 4; ++m) sr[m] = ((const __attribute__((address_space(1))) float*)g.sa)[cur.pm * BM + ai * HALF + wr * 64 + m * 16 + fr2];
#pragma unroll
                for (int bj = 0; bj < 2; ++bj)
#pragma unroll
                    for (int n = 0; n < 2; ++n) { const f32x4 sc = *(const __attribute__((address_space(1))) f32x4*)(g.sb + cur.pn * BM + bj * HALF + wc * 32 + 8 * fq2 + 4 * n);
#pragma unroll
                        for (int m = 0; m < 4; ++m) { const i32x4v t = __builtin_bit_cast(i32x4v, acc[ai][bj][m][n]); const float s = sr[m];
                            acc[ai][bj][m][n] = (f32x4){(float)t[0] * s * sc[0], (float)t[1] * s * sc[1], (float)t[2] * s * sc[2], (float)t[3] * s * sc[3]}; } }
            }
            __builtin_amdgcn_sched_barrier(0);
        }
        if constexpr (F8) asm volatile("s_nop 15\n\ts_nop 15" ::: "memory");
        if constexpr (ALIGN_EPI) { if (wr == 0) PG8_BAR; }
        if constexpr (!Epi::AFTER_DRAIN) { E(acc, cur, wr, wc, fr, fq); S.done(cur); }
        if (!has_next) break;
#pragma unroll
        for (int a = 0; a < 2; ++a)
#pragma unroll
            for (int b = 0; b < 2; ++b)
#pragma unroll
                for (int m = 0; m < 4; ++m)
#pragma unroll
                    for (int n = 0; n < 2; ++n) acc[a][b][m][n] = (f32x4){0.f, 0.f, 0.f, 0.f};
        cur = nxt; cA = nA; cB = nB; ++ui;
        if constexpr (ALIGN_EPI) { if (wr == 1) PG8_BAR; }
    }
    PG8_WAIT_V(0);
    if constexpr (!ALIGN_EPI) { if (wr == 0) PG8_BAR; }
    PG8_BAR;
    if constexpr (Epi::AFTER_DRAIN) { E.fused(acc, cur, wr, wc, fr, fq, lds, wid, lane); S.done(cur); }
#undef PG8_SA
#undef PG8_SB
#undef PG8_STAGE
#undef PG8_LDA
#undef PG8_LDB
#undef PG8_MMA
#undef PG8_LD16
#undef PG8_WAIT_V
#undef PG8_WAIT_L
#undef PG8_BAR
#undef PG8_SCHED
}
}
#ifndef PG8_SP2
#define PG8_SP2 true
#endif
#ifndef PG8_ALIGN
#define PG8_ALIGN true
#endif
constexpr int NWAVES = 8;
#ifndef MK_N_LAUNCHES
#define MK_N_LAUNCHES 1
#endif
constexpr int N_LAUNCHES = MK_N_LAUNCHES;
constexpr int PER_PHASE = 10;
#ifndef MK_DUP
#define MK_DUP -1
#endif
#ifndef MK_MLDUP
#define MK_MLDUP 0
#endif
#ifndef MK_NAIVE_ATTN
#define MK_NAIVE_ATTN 0
#endif
#ifndef MK_NAIVE_MLSTM
#define MK_NAIVE_MLSTM 0
#endif

constexpr int BATCH = 2, T = 8192, D = 4096, M = BATCH * T, FF = 16384;
constexpr int NCAT = 29952;
constexpr int W_IN_LD = 21520;
constexpr float RMS_EPS = 1e-6f;

constexpr size_t MiB = 1u << 20;
constexpr size_t WS_CTL = 0, CTL_ZERO_BYTES = 1 * MiB;
constexpr size_t WS_IFG = 1 * MiB, WS_LSE = 2 * MiB;
constexpr size_t WS_WATT = 8 * MiB, WS_WMLS = 16 * MiB, WS_WOUT = 48 * MiB, WS_WCAT = 80 * MiB, WS_XN = 314 * MiB;
constexpr size_t WS_QKV = 442 * MiB, WS_MQ = 730 * MiB, WS_MK = 794 * MiB, WS_MV = 858 * MiB, WS_MO = 986 * MiB;
constexpr size_t WS_AO = 80 * MiB, WS_HRAW = 176 * MiB, WS_ATT = 464 * MiB, WS_MLS = 496 * MiB, WS_WUP = 1114 * MiB, WS_WDOWN = 1242 * MiB;
constexpr size_t WS_XN8 = 1114 * MiB, WS_WG8 = WS_WCAT + (size_t)256 * (68 - PG8_NA8) * D * 2;
constexpr size_t WS_T1 = 794 * MiB, WS_MERGED = 80 * MiB, WS_HG = 848 * MiB, WS_U = 336 * MiB, WS_END = 1370 * MiB;
static_assert(WS_WCAT + (size_t)NCAT * D * 2 <= WS_XN && WS_XN + (size_t)M * D * 2 <= WS_QKV && WS_QKV + 3 * (size_t)M * 3072 * 2 <= WS_MQ, "ws map 1");
static_assert(WS_U + (size_t)M * FF * 2 <= WS_HG && WS_HG + (size_t)M * D * 2 <= WS_MO && WS_ATT >= WS_QKV && WS_ATT + (size_t)M * 1024 <= WS_MLS && WS_MLS + (size_t)M * D <= WS_MQ && WS_WDOWN + (size_t)D * FF * 2 <= WS_END && WS_MO + (size_t)M * D * 2 <= WS_WUP, "ws map 2");
constexpr int CW_TMO = 0, CW_CODE = 1, CW_BAR = 4096, CW_SS1 = 16384, CW_CMAX = 98304;
constexpr int NUP8 = 64;
constexpr size_t WS_SCL = 4 * MiB;
constexpr int SCL_SB = 0, SCL_SA = 65536, SCL_SAA = SCL_SA + 16384, SCL_SAM = SCL_SAA + 16384, SCL_SAG = SCL_SAM + 16384, SCL_SAH = SCL_SAG + 16384, SCL_XR = SCL_SAH + 16384;
static_assert(CW_CMAX + 58368 <= (int)(CTL_ZERO_BYTES / 4) && 58368 <= SCL_SA && WS_SCL + (size_t)(SCL_XR + 16384) * 4 <= 8 * MiB, "control / scale regions");
constexpr int CW_PAD_ = 0;
constexpr int CW_UNUSED = 0;
constexpr int RING_OFF = 0, RING_BYTES = 131072;
constexpr int LDSCTL_OFF = 150528, MISC_OFF = LDSCTL_OFF + 320;
constexpr int LDS_BYTES = 155648;
static_assert(MISC_OFF + 128 <= LDS_BYTES, "LDS map");

#define GAS __attribute__((address_space(1)))
#define LAS __attribute__((address_space(3)))
typedef unsigned short bf16;
typedef unsigned v4u __attribute__((ext_vector_type(4)));
typedef unsigned v2u __attribute__((ext_vector_type(2)));
typedef float f32x4 __attribute__((ext_vector_type(4)));
typedef GAS unsigned gu32;
#define RLX_AGENT __ATOMIC_RELAXED, __HIP_MEMORY_SCOPE_AGENT
#define LDS_WAIT() asm volatile("s_waitcnt lgkmcnt(0)" ::: "memory")
#define VM_WAIT() asm volatile("s_waitcnt vmcnt(0)" ::: "memory")
__device__ __forceinline__ unsigned f2bf(float f) { unsigned u = __builtin_bit_cast(unsigned, f); return (u + 0x7fffu + ((u >> 16) & 1u)) >> 16; }
__device__ __forceinline__ unsigned pk2(float lo, float hi) { return f2bf(lo) | (f2bf(hi) << 16); }
__device__ __forceinline__ float bflo(unsigned w) { return __uint_as_float(w << 16); }
__device__ __forceinline__ float bfhi(unsigned w) { return __uint_as_float(w & 0xffff0000u); }
__device__ __forceinline__ float bf2f(bf16 h) { return __uint_as_float(((unsigned)h) << 16); }

#define XB_TMO      128
#define XB_XCNT(j)  (256  + 64 * (j))
#define XB_XSUB(j)  (1280 + 64 * (j))
#define XB_XGEN(j)  (2304 + 64 * (j))
#define XB_TOP      3328
#define XB_TOPGEN   3392
#define XCD_BAR_WORDS 3456
#define XB_SPIN_CAP (1u << 22)

__device__ __forceinline__ unsigned xb_ld(unsigned* p)              { return __hip_atomic_load(p, __ATOMIC_RELAXED, __HIP_MEMORY_SCOPE_AGENT); }
__device__ __forceinline__ unsigned xb_add(unsigned* p, unsigned v) { return __hip_atomic_fetch_add(p, v, __ATOMIC_RELAXED, __HIP_MEMORY_SCOPE_AGENT); }
__device__ __forceinline__ unsigned xb_xcc_id() { return (unsigned)__builtin_amdgcn_s_getreg((3 << 11) | 20) & 0xFu; }
#define XB_SPIN(cond, bar) do { unsigned _sp = 0; while (cond) { __builtin_amdgcn_s_sleep(1); \
    if ((++_sp & 255u) == 0u) { if (xb_ld(&(bar)[XB_TMO])) break; if (_sp > XB_SPIN_CAP) { atomicAdd(&(bar)[XB_TMO], 1u); break; } } } } while (0)

struct XcdBarrier {
    unsigned* bar; unsigned x;
    volatile LAS unsigned* st;
};

__device__ __forceinline__ XcdBarrier xcd_barrier_post(unsigned* bar, volatile LAS unsigned* st) {
    XcdBarrier b; b.bar = bar; b.x = xb_xcc_id(); b.st = st;
    if (threadIdx.x == 0) (void)xb_add(&bar[XB_XCNT(b.x)], 1u);
    return b;
}
__device__ __forceinline__ void xcd_barrier_complete(unsigned* bar, unsigned x, unsigned& nloc, unsigned& nx) {
    const unsigned G = gridDim.x * gridDim.y * gridDim.z;
    unsigned sum, cnt, mine, sp = 0u;
    for (;;) {
        sum = 0u; cnt = 0u; mine = 0u;
#pragma unroll
        for (unsigned j = 0; j < 16; ++j) { const unsigned c = xb_ld(&bar[XB_XCNT(j)]); sum += c; cnt += (c > 0u) ? 1u : 0u; mine = (j == x) ? c : mine; }
        if (sum == G) break;
        __builtin_amdgcn_s_sleep(1);
        if ((++sp & 255u) == 0u) { if (xb_ld(&bar[XB_TMO])) break; if (sp > XB_SPIN_CAP) { atomicAdd(&bar[XB_TMO], 1u); break; } }
    }
    nloc = mine > 0u ? mine : 1u; nx = cnt > 0u ? cnt : 1u;
}

__device__ __forceinline__ void xcd_barrier(const XcdBarrier& b) {
    asm volatile("s_waitcnt vmcnt(0)" ::: "memory");
    __syncthreads();
    if (threadIdx.x == 0) {
        unsigned* bar = b.bar;
        __builtin_amdgcn_s_waitcnt(0);
        unsigned nloc = b.st[0], nx = b.st[1];
        if (nloc == 0u) { xcd_barrier_complete(bar, b.x, nloc, nx); b.st[0] = nloc; b.st[1] = nx; }
        const unsigned old = xb_add(&bar[XB_XSUB(b.x)], 1u);
        const unsigned gen = old / nloc;
        if (old + 1u == (gen + 1u) * nloc) {
            __builtin_amdgcn_fence(__ATOMIC_RELEASE, "agent");
            asm volatile("s_waitcnt vmcnt(0)" ::: "memory");
            const unsigned og = xb_add(&bar[XB_TOP], 1u);
            const unsigned tg = og / nx;
            if (og + 1u == (tg + 1u) * nx) xb_add(&bar[XB_TOPGEN], 1u);
            else XB_SPIN(xb_ld(&bar[XB_TOPGEN]) == tg, bar);
            __builtin_amdgcn_fence(__ATOMIC_ACQUIRE, "agent");
            xb_add(&bar[XB_XGEN(b.x)], 1u);
            asm volatile("s_waitcnt vmcnt(0)" ::: "memory");
        } else {
            XB_SPIN(xb_ld(&bar[XB_XGEN(b.x)]) == gen, bar);
            __builtin_amdgcn_fence(__ATOMIC_ACQUIRE, "agent");
            asm volatile("s_waitcnt vmcnt(0)" ::: "memory");
        }
    }
    __syncthreads();
}

typedef float f32x4v __attribute__((ext_vector_type(4)));
typedef short bf16x8v __attribute__((ext_vector_type(8)));
typedef short s16x4v __attribute__((ext_vector_type(4)));
typedef float f32x16 __attribute__((ext_vector_type(16)));
struct Ctx {
    LAS unsigned char* lds; int tid, lane, wave, G, bx;
};
__device__ __forceinline__ float wave_sum(float v) {
#pragma unroll
    for (int o = 1; o < 64; o <<= 1) v += __shfl_xor(v, o);
    return v;
}
__device__ __forceinline__ float wave_max(float v) {
#pragma unroll
    for (int o = 1; o < 64; o <<= 1) v = fmaxf(v, __shfl_xor(v, o));
    return v;
}
template <int F8OUT = 0>
__device__ __forceinline__ void p0_transpose_item(const float* W, int K, int ld, int c0, int nblk, int ncols, bf16* WT, int row_off, LAS float* scr, int item, int lane, const float* kscale = nullptr, const unsigned* cmax = nullptr, float* sb_out = nullptr) {
    const int kb = item / nblk, nb = item % nblk, k0 = 64 * kb, n0 = 32 * nb;
    const int c = lane & 7;
    unsigned cmv[4] = {0u, 0u, 0u, 0u};
    if (F8OUT == 2) {
#pragma unroll
        for (int j = 0; j < 4; ++j) { const int n = (lane >> 3) + 8 * j; if (n < ncols) cmv[j] = cmax[row_off + n0 + n]; } }
    f32x4 ks0 = {1.f, 1.f, 1.f, 1.f}, ks1 = ks0;
    if (kscale) { ks0 = *(const GAS f32x4*)(kscale + k0 + 8 * c); ks1 = *(const GAS f32x4*)(kscale + k0 + 8 * c + 4); }
    if ((lane & 31) < ncols) {
#pragma unroll 8
        for (int i = 0; i < 32; ++i) { const int kk = 2 * i + (lane >> 5); scr[kk * 33 + (lane & 31)] = W[(size_t)(k0 + kk) * ld + c0 + n0 + (lane & 31)]; }
    }
    LDS_WAIT(); asm volatile("" ::: "memory");
#pragma unroll
    for (int j = 0; j < 4; ++j) { const int n = (lane >> 3) + 8 * j; const LAS float* s = scr + (8 * c) * 33 + n;
        if (F8OUT == 2) { if (n < ncols) { const float cm = __uint_as_float(cmv[j]), qs = cm > 0.f ? 127.0f / cm : 0.f;
            if (kb == 0 && c == 0) sb_out[row_off + n0 + n] = cm * (1.0f / 127.0f);
            unsigned lo = 0, hi = 0;
#pragma unroll
            for (int e = 0; e < 4; ++e) { lo |= ((unsigned)(int)__builtin_rintf(fminf(fmaxf(s[e * 33] * ks0[e] * qs, -127.f), 127.f)) & 255u) << (8 * e); hi |= ((unsigned)(int)__builtin_rintf(fminf(fmaxf(s[(4 + e) * 33] * ks1[e] * qs, -127.f), 127.f)) & 255u) << (8 * e); }
            *(GAS v2u*)((GAS unsigned char*)WT + (size_t)(row_off + n0 + n) * K + k0 + 8 * c) = (v2u){lo, hi}; } }
        else if (F8OUT == 1) { if (n < ncols) { int lo = 0, hi = 0;
            lo = __builtin_amdgcn_cvt_pk_fp8_f32(s[0 * 33] * 64.f, s[1 * 33] * 64.f, lo, false); lo = __builtin_amdgcn_cvt_pk_fp8_f32(s[2 * 33] * 64.f, s[3 * 33] * 64.f, lo, true);
            hi = __builtin_amdgcn_cvt_pk_fp8_f32(s[4 * 33] * 64.f, s[5 * 33] * 64.f, hi, false); hi = __builtin_amdgcn_cvt_pk_fp8_f32(s[6 * 33] * 64.f, s[7 * 33] * 64.f, hi, true);
            *(GAS v2u*)((GAS unsigned char*)WT + (size_t)(row_off + n0 + n) * K + k0 + 8 * c) = (v2u){(unsigned)lo, (unsigned)hi}; } }
        else if (n < ncols) {
            v4u o; o.x = pk2(s[0 * 33] * ks0.x, s[1 * 33] * ks0.y); o.y = pk2(s[2 * 33] * ks0.z, s[3 * 33] * ks0.w); o.z = pk2(s[4 * 33] * ks1.x, s[5 * 33] * ks1.y); o.w = pk2(s[6 * 33] * ks1.z, s[7 * 33] * ks1.w);
            *(GAS v4u*)(WT + (size_t)(row_off + n0 + n) * K + k0 + 8 * c) = o; } }
    LDS_WAIT(); asm volatile("" ::: "memory");
}
__device__ __forceinline__ void rms_row_to_bf16(const float* xrow, const float* g, bf16* orow, int lane, unsigned char* o8row = nullptr, float* sa_out = nullptr, float* inv_rstd = nullptr) {
    const GAS f32x4* xr = (const GAS f32x4*)xrow + lane; const GAS f32x4* gr = (const GAS f32x4*)g + lane;
    f32x4 v[16]; float s = 0.f;
#pragma unroll
    for (int j = 0; j < 16; ++j) { v[j] = xr[64 * j]; s += (v[j].x * v[j].x + v[j].y * v[j].y) + (v[j].z * v[j].z + v[j].w * v[j].w); }
    const float rt = sqrtf(wave_sum(s) * (1.f / D) + RMS_EPS), rstd = 1.f / rt;
    if (inv_rstd && lane == 0) *inv_rstd = rt;
    GAS v2u* o8 = (GAS v2u*)orow + lane;
    float ymax = 0.f;
#pragma unroll
    for (int j = 0; j < 16; ++j) { const f32x4 gg = gr[64 * j]; v[j].x *= rstd * gg.x; v[j].y *= rstd * gg.y; v[j].z *= rstd * gg.z; v[j].w *= rstd * gg.w;
        v2u w; w.x = pk2(v[j].x, v[j].y); w.y = pk2(v[j].z, v[j].w); o8[64 * j] = w;
        ymax = fmaxf(ymax, fmaxf(fmaxf(fabsf(v[j].x), fabsf(v[j].y)), fmaxf(fabsf(v[j].z), fabsf(v[j].w)))); }
    if (o8row) { ymax = wave_max(ymax); const float qs = ymax > 0.f ? 127.0f / ymax : 0.f;
        if (lane == 0) *sa_out = ymax * (1.0f / 127.0f);
#pragma unroll
        for (int j = 0; j < 16; ++j) { const unsigned q = ((unsigned)(int)__builtin_rintf(fminf(fmaxf(v[j].x * qs, -127.f), 127.f)) & 255u) | (((unsigned)(int)__builtin_rintf(fminf(fmaxf(v[j].y * qs, -127.f), 127.f)) & 255u) << 8) | (((unsigned)(int)__builtin_rintf(fminf(fmaxf(v[j].z * qs, -127.f), 127.f)) & 255u) << 16) | (((unsigned)(int)__builtin_rintf(fminf(fmaxf(v[j].w * qs, -127.f), 127.f)) & 255u) << 24);
            ((GAS unsigned*)o8row)[lane + 64 * j] = q; } }
}
struct P0Args { const float *x, *g_mix, *w_in, *w_attn, *w_mlstm, *w_gate, *w_out, *w_up, *g_mlp; bf16 *WCAT, *WATT, *WMLS, *WOUT, *XN; float* SS; unsigned char *XNQ, *WQ; float* SA; unsigned* CMAX; float* SB; float* XR; };
__device__ __forceinline__ void p0_pass_a(const Ctx& F, const P0Args& A) {
    const int gw = F.bx * NWAVES + F.wave, NGW = F.G * NWAVES, lane = F.lane;
    for (int it = gw; it < 116 * 16 + 64 + 256 + 256 + NUP8 * 16; it += NGW) {
        const float* W; int ld, c0, k0, co; const float* ksc = nullptr;
        if (it < 116 * 16) { const int cc = it % 116, kc = it / 116; W = cc < 84 ? A.w_in : A.w_gate; ld = cc < 84 ? W_IN_LD : 8192; c0 = cc < 84 ? 256 * cc : 256 * (cc - 84); k0 = 256 * kc; co = 256 * cc; }
        else if (it < 116 * 16 + 64) { const int r = it - 116 * 16; W = A.w_attn; ld = D; c0 = 256 * (r & 15); k0 = 256 * (r >> 4); co = 29696 + c0; }
        else if (it < 116 * 16 + 64 + 256) { const int r = it - 116 * 16 - 64; W = A.w_mlstm; ld = D; c0 = 256 * (r & 15); k0 = 256 * (r >> 4); co = 33792 + c0; }
        else if (it < 116 * 16 + 64 + 256 + 256) { const int r = it - 116 * 16 - 64 - 256; W = A.w_out; ld = D; c0 = 256 * (r & 15); k0 = 256 * (r >> 4); co = 37888 + c0; }
        else { const int r = it - 116 * 16 - 64 - 256 - 256; W = A.w_up; ld = FF; c0 = 256 * (r % NUP8); k0 = 256 * (r / NUP8); co = 41984 + c0; ksc = A.g_mlp + k0; }
        const GAS f32x4* p = (const GAS f32x4*)(W + (size_t)k0 * ld + c0) + lane;
        f32x4 mx = {0.f, 0.f, 0.f, 0.f};
#pragma unroll 16
        for (int k = 0; k < 256; ++k) { f32x4 v = *(const GAS f32x4*)((const GAS float*)p + (size_t)k * ld); if (ksc) v *= ksc[k];
            mx.x = fmaxf(mx.x, fabsf(v.x)); mx.y = fmaxf(mx.y, fabsf(v.y)); mx.z = fmaxf(mx.z, fabsf(v.z)); mx.w = fmaxf(mx.w, fabsf(v.w)); }
        unsigned* cm = A.CMAX + co + 4 * lane;
        atomicMax(cm + 0, __float_as_uint(mx.x)); atomicMax(cm + 1, __float_as_uint(mx.y)); atomicMax(cm + 2, __float_as_uint(mx.z)); atomicMax(cm + 3, __float_as_uint(mx.w));
    }
    { GAS v4u* z = (GAS v4u*)(A.WCAT + (size_t)29712 * D); const int gt = F.bx * (NWAVES * 64) + F.tid, NT = F.G * NWAVES * 64;
      for (int i = gt; i < 240 * D / 8; i += NT) z[i] = (v4u){0u, 0u, 0u, 0u}; }
    for (int m = gw; m < M; m += NGW) rms_row_to_bf16(A.x + (size_t)m * D, A.g_mix, A.XN + (size_t)m * D, lane, A.XNQ + (size_t)m * D, A.SA + m, A.XR + m);
    { const int gt = F.bx * (NWAVES * 64) + F.tid, NT = F.G * NWAVES * 64; for (int i = gt; i < 2 * M; i += NT) A.SS[i] = 0.f; }
}
__device__ __forceinline__ void p0_prologue(const Ctx& F, const P0Args& A) {
    LAS float* scr = (LAS float*)(F.lds + RING_OFF + F.wave * 16384);
    const int gw = F.bx * NWAVES + F.wave, NGW = F.G * NWAVES;
    constexpr int I_IN = 64 * 672, I_GATE = 64 * 256, I_IF = 64, I_ATT = 16 * 128, I_MLS = 64 * 128, I_OUT = 64 * 128, I_MQK = 64 * 128;
    constexpr int NITEMS = I_IN + I_GATE + I_IF + I_ATT + I_MLS + I_OUT + I_MQK;
    for (int it = gw; it < NITEMS; it += NGW) {
        int r = it;
        if (r < I_MQK) { p0_transpose_item(A.w_in, D, W_IN_LD, 9216, 128, 32, A.WCAT + (size_t)14848 * D, 0, scr, r, F.lane); continue; } r -= I_MQK;
        if (r < I_IN) { p0_transpose_item<2>(A.w_in, D, W_IN_LD, 0, 672, 32, (bf16*)A.WQ, 0, scr, r, F.lane, nullptr, A.CMAX, A.SB); continue; } r -= I_IN;
        if (r < I_GATE) { p0_transpose_item<2>(A.w_gate, D, 8192, 0, 256, 32, (bf16*)A.WQ, 21504, scr, r, F.lane, nullptr, A.CMAX, A.SB); continue; } r -= I_GATE;
        if (r < I_IF) { p0_transpose_item(A.w_in, D, W_IN_LD, 21504, 1, 16, A.WCAT, 29696, scr, r, F.lane); continue; } r -= I_IF;
        if (r < I_ATT) { p0_transpose_item<2>(A.w_attn, 1024, D, 0, 128, 32, A.WATT, 0, scr, r, F.lane, nullptr, A.CMAX + 29696, A.SB + 29696); continue; } r -= I_ATT;
        if (r < I_MLS) { p0_transpose_item<2>(A.w_mlstm, D, D, 0, 128, 32, A.WMLS, 0, scr, r, F.lane, nullptr, A.CMAX + 33792, A.SB + 33792); continue; } r -= I_MLS;
        p0_transpose_item<2>(A.w_out, D, D, 0, 128, 32, A.WOUT, 0, scr, r, F.lane, nullptr, A.CMAX + 37888, A.SB + 37888);
    }
}
__device__ __forceinline__ void p1_if_gates(const Ctx& F, const bf16* XN, const bf16* WIF, float* IFG) {
    const int gw = F.wave * F.G + F.bx, NGW = F.G * NWAVES, fr = F.lane & 15, fq = F.lane >> 4;
    for (int task = gw; task < M / 16; task += NGW) {
        const bf16* ap = XN + (size_t)(task * 16 + fr) * D + 8 * fq; const bf16* bp = WIF + (size_t)fr * D + 8 * fq;
        f32x4v acc[4];
#pragma unroll
        for (int u = 0; u < 4; ++u) acc[u] = (f32x4v){0.f, 0.f, 0.f, 0.f};
        for (int ks = 0; ks < 128; ks += 16) {
            bf16x8v a[16], b[16];
#pragma unroll
            for (int u = 0; u < 16; ++u) { a[u] = *(const GAS bf16x8v*)(ap + 32 * (ks + u)); b[u] = *(const GAS bf16x8v*)(bp + 32 * (ks + u)); }
#pragma unroll
            for (int u = 0; u < 16; ++u) acc[u & 3] = __builtin_amdgcn_mfma_f32_16x16x32_bf16(a[u], b[u], acc[u & 3], 0, 0, 0);
        }
        const f32x4v r = (acc[0] + acc[1]) + (acc[2] + acc[3]);
#pragma unroll
        for (int i = 0; i < 4; ++i) IFG[(size_t)(task * 16 + 4 * fq + i) * 16 + fr] = r[i];
    }
}
__device__ __forceinline__ float dot8(const v4u q, const v4u k) {
    return (bflo(q.x) * bflo(k.x) + bfhi(q.x) * bfhi(k.x)) + (bflo(q.y) * bflo(k.y) + bfhi(q.y) * bfhi(k.y)) + (bflo(q.z) * bflo(k.z) + bfhi(q.z) * bfhi(k.z)) + (bflo(q.w) * bflo(k.w) + bfhi(q.w) * bfhi(k.w));
}
__device__ __forceinline__ float alibi_slope(int g, int h) { const float x = g == 0 ? 0.25f * (h + 1) : g == 1 ? 2.0f + 0.25f * (h + 1) : 4.0f + 0.5f * (h + 1); return exp2f(-x); }
__device__ __forceinline__ void attn_naive(const Ctx& F, const bf16* QKV, bf16* AO, float* LSE) {
    const int gw = F.bx * NWAVES + F.wave, NGW = F.G * NWAVES, lane = F.lane;
    for (int it = gw; it < 3 * 2 * 8 * 256; it += NGW) {
        const int g = it / 4096, rem = it % 4096, b = rem / 2048, rem2 = rem % 2048, h = rem2 / 256, ck = rem2 % 256;
        const int sh = 2 * g, d = 1 << sh, L = 8192 >> sh, pos0 = ck * 32, r = pos0 / L, j0 = pos0 % L;
        const size_t seq = (size_t)g * pg8::ATT_G + (((size_t)(b * 8 + h) << 13) + (size_t)r * L) * 128;
        const bf16* Qs = QKV + seq; const bf16* Ks = QKV + pg8::ATT_T + seq; const bf16* Vs = QKV + 2 * pg8::ATT_T + seq;
        const float sd = alibi_slope(g, h) * (float)d, scale = 0.08838834764831845f;
        for (int qi = 0; qi < 32; ++qi) {
            const int j = j0 + qi;
            const bool v0 = (j - lane) >= 0, v1 = (j - lane - 64) >= 0, v2 = (lane == 0) && (j - 128 >= 0);
            const GAS v4u* qp = (const GAS v4u*)(Qs + (size_t)j * 128);
            const GAS v4u* k0 = (const GAS v4u*)(Ks + (size_t)(v0 ? j - lane : 0) * 128);
            const GAS v4u* k1 = (const GAS v4u*)(Ks + (size_t)(v1 ? j - lane - 64 : 0) * 128);
            const GAS v4u* k2 = (const GAS v4u*)(Ks + (size_t)(v2 ? j - 128 : 0) * 128);
            float s0 = 0.f, s1 = 0.f, s2 = 0.f;
#pragma unroll 4
            for (int c = 0; c < 16; ++c) { const v4u qv = qp[c]; s0 += dot8(qv, k0[c]); s1 += dot8(qv, k1[c]); s2 += dot8(qv, k2[c]); }
            const float NEGI = -__builtin_inff();
            s0 = v0 ? s0 * scale - sd * (float)lane : NEGI; s1 = v1 ? s1 * scale - sd * (float)(lane + 64) : NEGI; s2 = v2 ? s2 * scale - sd * 128.f : NEGI;
            const float mx = wave_max(fmaxf(s0, fmaxf(s1, s2)));
            const float p0 = v0 ? __expf(s0 - mx) : 0.f, p1 = v1 ? __expf(s1 - mx) : 0.f, p2 = v2 ? __expf(s2 - mx) : 0.f;
            const float sum = wave_sum(p0 + p1 + p2);
            const int nk = (j < 128 ? j : 128) + 1;
            float a0 = 0.f, a1 = 0.f;
            for (int rel = 0; rel < nk; ++rel) {
                const float p = rel < 64 ? __shfl(p0, rel) : (rel < 128 ? __shfl(p1, rel - 64) : __shfl(p2, 0));
                const unsigned vv = ((const GAS unsigned*)(Vs + (size_t)(j - rel) * 128))[lane];
                a0 += p * bflo(vv); a1 += p * bfhi(vv);
            }
            const float inv = 1.0f / sum;
            const size_t m = (size_t)b * T + r + (size_t)d * j;
            ((GAS unsigned*)(AO + (size_t)g * pg8::ATT_G + m * 1024 + h * 128))[lane] = pk2(a0 * inv, a1 * inv);
            if (lane == 0) LSE[((size_t)g * M + m) * 8 + h] = mx + __logf(sum);
        }
    }
}
constexpr int AV_PITCH = 272;
constexpr int AV_WAVE_BYTES = 32 * AV_PITCH;
__device__ __forceinline__ void attn_fast(const Ctx& F, const bf16* QKV, bf16* AO, float* LSE, const float* w_up, const float* w_down, bf16* WUP, bf16* WDOWN, const float* g_mlp, const unsigned* cmax_up, float* sb_up, int wg_rank, int wg_count) {
    const int gw = wg_rank * NWAVES + F.wave, NGW = wg_count * NWAVES, lane = F.lane, c = lane & 31, hi = lane >> 5;
    LAS unsigned char* vimg = F.lds + RING_OFF + F.wave * AV_WAVE_BYTES;
    LAS float* tscr = (LAS float*)(F.lds + RING_OFF + NWAVES * AV_WAVE_BYTES + F.wave * 8448);
    static_assert(NWAVES * (AV_WAVE_BYTES + 8448) <= LDSCTL_OFF, "per-wave V images + copy tiles inside the phase scratch");
    const int trb = (4 * hi + ((lane & 15) >> 2)) * AV_PITCH + ((lane >> 4) & 1) * 32 + (lane & 3) * 8;
    const int strow = lane >> 4, stcol = (lane & 15) * 16;
    for (int it = gw; it < 3 * 2 * 8 * 256; it += NGW) {
        const int g = it / 4096, rem = it % 4096, b = rem / 2048, rem2 = rem % 2048, h = rem2 / 256, ck = rem2 % 256;
        const int sh = 2 * g, d = 1 << sh, L = 8192 >> sh, pos0 = ck * 32, r = pos0 / L, q0 = pos0 % L;
        const size_t seq = (size_t)g * pg8::ATT_G + (((size_t)(b * 8 + h) << 13) + (size_t)r * L) * 128;
        const bf16* Qs = QKV + seq; const bf16* Ks = QKV + pg8::ATT_T + seq; const bf16* Vs = QKV + 2 * pg8::ATT_T + seq;
        const float sdl = alibi_slope(g, h) * (float)d * 1.4426950408889634f, scl = 0.08838834764831845f * 1.4426950408889634f;
        const int kb_lo = q0 >= 128 ? 0 : (128 - q0) >> 5;
        const int kbase = q0 - 128;
        bf16x8v qf[8];
#pragma unroll
        for (int s = 0; s < 8; ++s) qf[s] = *(const GAS bf16x8v*)(Qs + (size_t)(q0 + c) * 128 + 16 * s + 8 * hi);
        f32x16 S[5];
#pragma unroll
        for (int kb = 0; kb < 5; ++kb) {
#pragma unroll
            for (int q = 0; q < 16; ++q) S[kb][q] = 0.f;
            if (kb >= kb_lo) {
                const bf16* kp = Ks + (size_t)(kbase + 32 * kb + c) * 128 + 8 * hi;
#pragma unroll
                for (int s = 0; s < 8; ++s) { const bf16x8v kf = *(const GAS bf16x8v*)(kp + 16 * s); S[kb] = __builtin_amdgcn_mfma_f32_32x32x16_bf16(kf, qf[s], S[kb], 0, 0, 0); }
            }
            asm volatile("" ::: "memory");
        }
        int lo_ = lane; asm volatile("" : "+v"(lo_));
        const int dd = (lo_ & 31) - 4 * (lo_ >> 5);
        const float base = -sdl * (float)dd, nsdl = -sdl;
        const float NEGI = -__builtin_inff(); float mx = NEGI;
#pragma unroll
        for (int kb = 0; kb < 5; ++kb)
#pragma unroll
            for (int q = 0; q < 16; ++q) { const int cq = (q & 3) + 8 * (q >> 2);
                float t = __builtin_fmaf(S[kb][q], scl, __builtin_fmaf(nsdl, (float)(128 - 32 * kb - cq), base));
                const bool ok = (kb >= kb_lo) && (kb != 0 || dd <= cq) && (kb != 4 || dd >= cq);
                t = ok ? t : NEGI; S[kb][q] = t; mx = fmaxf(mx, t); }
        mx = fmaxf(mx, __shfl_xor(mx, 32));
        float lsum = 0.f;
        bf16x8v pf[5][2];
#pragma unroll
        for (int kb = 0; kb < 5; ++kb) {
#pragma unroll
            for (int q = 0; q < 16; ++q) { const float p = __builtin_amdgcn_exp2f(S[kb][q] - mx); S[kb][q] = p; lsum += p; }
#pragma unroll
            for (int s2 = 0; s2 < 2; ++s2) {
                pg8::u32x4 pw; pw.x = pg8::cvt_pk_bf16(S[kb][8 * s2 + 0], S[kb][8 * s2 + 1]); pw.y = pg8::cvt_pk_bf16(S[kb][8 * s2 + 2], S[kb][8 * s2 + 3]);
                pw.z = pg8::cvt_pk_bf16(S[kb][8 * s2 + 4], S[kb][8 * s2 + 5]); pw.w = pg8::cvt_pk_bf16(S[kb][8 * s2 + 6], S[kb][8 * s2 + 7]);
                pf[kb][s2] = __builtin_bit_cast(bf16x8v, pw); }
        }
        lsum += __shfl_xor(lsum, 32);
        __builtin_amdgcn_sched_barrier(0);
        f32x16 o[4];
#pragma unroll
        for (int db = 0; db < 4; ++db)
#pragma unroll
            for (int q = 0; q < 16; ++q) o[db][q] = 0.f;
#pragma unroll
        for (int kb = 0; kb < 5; ++kb) {
            asm volatile("" ::: "memory");
            if (kb >= kb_lo) {
                LAS unsigned char* img = vimg;
                const bf16* vp = Vs + (size_t)(kbase + 32 * kb) * 128;
#pragma unroll
                for (int i = 0; i < 8; ++i) { const v4u w = *(const GAS v4u*)(vp + (size_t)(4 * i + strow) * 128 + (stcol >> 1)); *(LAS v4u*)(img + (4 * i + strow) * AV_PITCH + stcol) = w; }
#pragma unroll
                for (int s2 = 0; s2 < 2; ++s2) {
#pragma unroll
                    for (int db = 0; db < 4; ++db) {
                        const s16x4v lo = __builtin_amdgcn_ds_read_tr16_b64_v4i16((LAS s16x4v*)(img + trb + (16 * s2) * AV_PITCH + 64 * db));
                        const s16x4v hv = __builtin_amdgcn_ds_read_tr16_b64_v4i16((LAS s16x4v*)(img + trb + (16 * s2 + 8) * AV_PITCH + 64 * db));
                        const bf16x8v vf = __builtin_shufflevector(lo, hv, 0, 1, 2, 3, 4, 5, 6, 7);
                        o[db] = __builtin_amdgcn_mfma_f32_32x32x16_bf16(vf, pf[kb][s2], o[db], 0, 0, 0);
                    }
                }
            }
        }
        const float inv = 1.0f / lsum;
        const size_t m = (size_t)b * T + r + (size_t)d * (q0 + c);
        bf16* orow = AO + (size_t)g * pg8::ATT_G + m * 1024 + h * 128;
#pragma unroll
        for (int db = 0; db < 4; ++db)
#pragma unroll
            for (int kp = 0; kp < 2; ++kp) {
                unsigned ax = pg8::cvt_pk_bf16(o[db][8 * kp] * inv, o[db][8 * kp + 1] * inv), ay = pg8::cvt_pk_bf16(o[db][8 * kp + 2] * inv, o[db][8 * kp + 3] * inv);
                unsigned bx = pg8::cvt_pk_bf16(o[db][8 * kp + 4] * inv, o[db][8 * kp + 5] * inv), by = pg8::cvt_pk_bf16(o[db][8 * kp + 6] * inv, o[db][8 * kp + 7] * inv);
                { const auto r = __builtin_amdgcn_permlane32_swap(ax, bx, false, false); ax = r[0]; bx = r[1]; }
                { const auto r = __builtin_amdgcn_permlane32_swap(ay, by, false, false); ay = r[0]; by = r[1]; }
                *(GAS v4u*)(orow + 32 * db + 16 * kp + 8 * hi) = (v4u){ax, ay, bx, by}; }
        if (hi == 0) LSE[((size_t)g * M + m) * 8 + h] = (mx + __builtin_amdgcn_logf(lsum)) * 0.6931471805599453f;
        for (int ci = (it * 16) / 3; ci < ((it + 1) * 16) / 3; ++ci) {
            if (ci < 64 * 512) { if ((ci & 511) < 8 * NUP8) p0_transpose_item<2>(w_up, D, FF, 0, 512, 32, WUP, 0, tscr, ci, lane, g_mlp, cmax_up, sb_up);
                                 else p0_transpose_item(w_up, D, FF, 0, 512, 32, WUP, 0, tscr, ci, lane, g_mlp); }
            else p0_transpose_item(w_down, FF, D, 0, 128, 32, WDOWN, 0, tscr, ci - 64 * 512, lane);
        }
    }
}
__device__ __forceinline__ float softcap15(float x) { return 15.0f * tanhf(x * (1.0f / 15.0f)); }
__device__ __forceinline__ void mlstm_naive(const Ctx& F, const bf16* MQ, const bf16* MK, const bf16* MV, const float* IFG, const float* b_i, const float* b_f, bf16* HRAW) {
    LAS bf16* qs = (LAS bf16*)(F.lds + RING_OFF); LAS bf16* ks = qs + 64 * 256; LAS bf16* vs = ks + 64 * 256;
    LAS float* gi = (LAS float*)(vs + 64 * 32); LAS float* gf = gi + 64; LAS float* red = gf + 64; LAS float* rden = red + 1024;
    const int tid = F.tid, j = tid & 31, eg = tid >> 5;
    for (int item = F.bx; item < 256; item += F.G) {
        const int b = item >> 7, h = (item >> 4) & 7, vsl = item & 15;
        float C[16], n[16];
#pragma unroll
        for (int e = 0; e < 16; ++e) { C[e] = 0.f; n[e] = 0.f; }
        const float bi = b_i[h], bfv = b_f[h];
        for (int chunk = 0; chunk < 128; ++chunk) {
            const size_t m0 = (size_t)b * T + chunk * 64;
            __syncthreads();
#pragma unroll
            for (int i = 0; i < 4; ++i) { const int idx = tid + 512 * i, row = idx >> 5, c16 = idx & 31;
                *(LAS v4u*)(qs + row * 256 + c16 * 8) = *(const GAS v4u*)(MQ + (m0 + row) * 2048 + h * 256 + c16 * 8);
                *(LAS v4u*)(ks + row * 256 + c16 * 8) = *(const GAS v4u*)(MK + (m0 + row) * 2048 + h * 256 + c16 * 8); }
            if (tid < 256) { const int row = tid >> 2, c = tid & 3; *(LAS v4u*)(vs + row * 32 + c * 8) = *(const GAS v4u*)(MV + (m0 + row) * 4096 + h * 512 + vsl * 32 + c * 8); }
            if (tid < 64) { const float ri = IFG[(m0 + tid) * 16 + h] + bi, rf = IFG[(m0 + tid) * 16 + 8 + h] + bfv;
                gi[tid] = __expf(softcap15(ri)); gf[tid] = 1.0f / (1.0f + __expf(-softcap15(rf))); }
            __syncthreads();
            for (int t = 0; t < 64; ++t) {
                const float f = gf[t], ig = gi[t], vj = bf2f(vs[t * 32 + j]);
                const v4u kw0 = *(const LAS v4u*)(ks + t * 256 + eg * 16), kw1 = *(const LAS v4u*)(ks + t * 256 + eg * 16 + 8);
                const v4u qw0 = *(const LAS v4u*)(qs + t * 256 + eg * 16), qw1 = *(const LAS v4u*)(qs + t * 256 + eg * 16 + 8);
                const unsigned kw[8] = {kw0.x, kw0.y, kw0.z, kw0.w, kw1.x, kw1.y, kw1.z, kw1.w}, qw[8] = {qw0.x, qw0.y, qw0.z, qw0.w, qw1.x, qw1.y, qw1.z, qw1.w};
                float pn = 0.f, pd = 0.f;
#pragma unroll
                for (int e2 = 0; e2 < 8; ++e2) {
                    { const float ik = ig * bflo(kw[e2]), qq = bflo(qw[e2]); C[2 * e2] = f * C[2 * e2] + ik * vj; n[2 * e2] = f * n[2 * e2] + ik; pn += qq * C[2 * e2]; pd += qq * n[2 * e2]; }
                    { const float ik = ig * bfhi(kw[e2]), qq = bfhi(qw[e2]); C[2 * e2 + 1] = f * C[2 * e2 + 1] + ik * vj; n[2 * e2 + 1] = f * n[2 * e2 + 1] + ik; pn += qq * C[2 * e2 + 1]; pd += qq * n[2 * e2 + 1]; }
                }
                const int buf = t & 1;
                red[buf * 512 + eg * 32 + j] = pn; if (j == 0) rden[buf * 16 + eg] = pd;
                __syncthreads();
                if (tid < 32) { float num = 0.f, den = 0.f;
#pragma unroll
                    for (int q = 0; q < 16; ++q) { num += red[buf * 512 + q * 32 + tid]; den += rden[buf * 16 + q]; }
                    HRAW[(m0 + t) * 4096 + h * 512 + vsl * 32 + tid] = (bf16)f2bf(num / fmaxf(fabsf(den), 1.0f)); }
            }
        }
    }
}
namespace ml {
constexpr int QP = 528;
constexpr int NVT = 4, NCT = NVT + 1, VW = 16 * NVT;
constexpr int VP = VW * 2 + 16;
constexpr int O_Q = 0, O_K = 64 * QP, O_CT = 2 * 64 * QP, O_V = O_CT + 16 * NCT * QP, O_WV = O_V + 64 * VP, O_HI = O_WV + 64 * VP, HIP = VW + 1;
constexpr int GSZ = 1536;
constexpr int O_G = O_HI + 64 * HIP * 4, O_DI = O_G + 2 * GSZ, O_END = O_DI + 256;
static_assert(16 * VP <= 16 * HIP * 4 && ((16 * HIP * 4) % 16) == 0, "output transpose tile inside a wave's 16 H_intra rows");
static_assert(O_END <= LDSCTL_OFF && (O_HI % 16) == 0 && (O_G % 16) == 0 && (GSZ % 16) == 0 && (O_V % 16) == 0 && (VP % 16) == 0, "mLSTM LDS map");
}
#define ML_DPPF(old, src, ctrl, rmask) __builtin_bit_cast(float, __builtin_amdgcn_update_dpp(__builtin_bit_cast(int, (float)(old)), __builtin_bit_cast(int, (float)(src)), ctrl, rmask, 0xf, false))
__device__ __forceinline__ float lane_scan_add(float v) {
    v += ML_DPPF(0.f, v, 0x111, 0xf); v += ML_DPPF(0.f, v, 0x112, 0xf); v += ML_DPPF(0.f, v, 0x114, 0xf); v += ML_DPPF(0.f, v, 0x118, 0xf);
    v += ML_DPPF(0.f, v, 0x142, 0xa); v += ML_DPPF(0.f, v, 0x143, 0xc); return v;
}
__device__ __forceinline__ float lane_scan_max(float v) {
    const float NI = -__builtin_inff();
    v = fmaxf(v, ML_DPPF(NI, v, 0x111, 0xf)); v = fmaxf(v, ML_DPPF(NI, v, 0x112, 0xf)); v = fmaxf(v, ML_DPPF(NI, v, 0x114, 0xf)); v = fmaxf(v, ML_DPPF(NI, v, 0x118, 0xf));
    v = fmaxf(v, ML_DPPF(NI, v, 0x142, 0xa)); v = fmaxf(v, ML_DPPF(NI, v, 0x143, 0xc)); return v;
}
__device__ __forceinline__ float softcap15_fast(float x) { const float e = __expf(x * (2.0f / 15.0f)); return 15.0f - 30.0f * __builtin_amdgcn_rcpf(e + 1.0f); }
__device__ __forceinline__ bf16x8v pack8v(float a0, float a1, float a2, float a3, float a4, float a5, float a6, float a7) {
    pg8::u32x4 w; w.x = pg8::cvt_pk_bf16(a0, a1); w.y = pg8::cvt_pk_bf16(a2, a3); w.z = pg8::cvt_pk_bf16(a4, a5); w.w = pg8::cvt_pk_bf16(a6, a7); return __builtin_bit_cast(bf16x8v, w);
}
__device__ __forceinline__ bf16x8v tr_pair(LAS unsigned char* p0, LAS unsigned char* p1) {
    const s16x4v lo = __builtin_amdgcn_ds_read_tr16_b64_v4i16((LAS s16x4v*)p0), hv = __builtin_amdgcn_ds_read_tr16_b64_v4i16((LAS s16x4v*)p1);
    return __builtin_shufflevector(lo, hv, 0, 1, 2, 3, 4, 5, 6, 7);
}
#define ML_LDS_BARRIER() do { asm volatile("s_waitcnt lgkmcnt(0)" ::: "memory"); __builtin_amdgcn_s_barrier(); asm volatile("" ::: "memory"); } while (0)
__device__ __forceinline__ void mlstm_gates(float gi_pre, float gf_pre, float bi, float bfv, float& m_prev, int lane, LAS float* G) {
    const float li = softcap15_fast(gi_pre + bi), xf = softcap15_fast(gf_pre + bfv), lf = -(fmaxf(-xf, 0.f) + __logf(1.0f + __expf(-fabsf(xf))));
    const float bb = lane_scan_add(lf), a = li - bb, pm = lane_scan_max(a);
    const float Mt = fmaxf(m_prev, pm), M63 = __shfl(Mt, 63), b63 = __shfl(bb, 63);
    G[lane] = a * 1.4426950408889634f; G[64 + lane] = Mt * 1.4426950408889634f;
    G[128 + lane] = __expf(m_prev - Mt); G[192 + lane] = __expf(-(bb + Mt)); G[256 + lane] = __expf(a - M63);
    if (lane == 0) G[320] = __expf(m_prev - M63);
    m_prev = b63 + M63;
}
__device__ __forceinline__ void mlstm_fast(const Ctx& F, const bf16* MQ, const bf16* MK, const bf16* MV, const float* IFG, const float* b_i, const float* b_f, bf16* HRAW, int wg_rank, int wg_count) {
    using namespace ml;
    constexpr int NITEM = 16 * (512 / VW);
    LAS unsigned char* L = F.lds + RING_OFF;
    const int tid = F.tid, lane = F.lane, w = F.wave, fr = lane & 15, fq = lane >> 4;
    LAS float* diL = (LAS float*)(L + O_DI); LAS float* hiL = (LAS float*)(L + O_HI);
    const int trq = (lane & 15) >> 2, trp = lane & 3;
    for (int item = wg_rank; item < NITEM; item += wg_count) {
        const int bh = (item & 3) * 4 + (item >> 5), vsl = (item >> 2) & 7, b = bh >> 3, h = bh & 7;
        const float bi = b_i[h], bfv = b_f[h];
        const bf16* qg = MQ + (size_t)b * T * 2048 + h * 256; const bf16* kg = MK + (size_t)b * T * 2048 + h * 256;
        const bf16* vg = MV + (size_t)b * T * 4096 + h * 512 + vsl * VW; const float* ig = IFG + (size_t)b * T * 16 + h;
        bf16* hg = HRAW + (size_t)b * T * 4096 + h * 512 + vsl * VW;
        __syncthreads();
        const int ne = 2, e0 = 2 * w;
        f32x4v Cm[2][NCT];
#pragma unroll
        for (int x = 0; x < 2; ++x)
#pragma unroll
            for (int y = 0; y < NCT; ++y) Cm[x][y] = (f32x4v){0.f, 0.f, 0.f, 0.f};
        for (int i = tid; i < 16 * NCT * QP / 16; i += 512) *(LAS v4u*)(L + O_CT + i * 16) = (v4u){0u, 0u, 0u, 0u};
        float m_prev = -1e30f;
        v4u pq[4], pk[4], pv; float gi_pre = 0.f, gf_pre = 0.f;
#pragma unroll
        for (int i = 0; i < 4; ++i) { const int idx = tid + 512 * i, row = idx >> 5, c16 = idx & 31;
            pq[i] = *(const GAS v4u*)(qg + (size_t)row * 2048 + c16 * 8); pk[i] = *(const GAS v4u*)(kg + (size_t)row * 2048 + c16 * 8); }
        pv = *(const GAS v4u*)(vg + (size_t)(tid >> 3) * 4096 + (tid & 7) * 8);
        if (w == 0) { mlstm_gates(ig[(size_t)lane * 16], ig[(size_t)lane * 16 + 8], bi, bfv, m_prev, lane, (LAS float*)(L + O_G));
                      gi_pre = ig[(size_t)(64 + lane) * 16]; gf_pre = ig[(size_t)(64 + lane) * 16 + 8]; }
        ML_LDS_BARRIER();
        for (int chunk = 0; chunk < 128; ++chunk) {
            const size_t m0 = (size_t)chunk * 64;
            LAS float* G = (LAS float*)(L + O_G + (chunk & 1) * GSZ);
            LAS float* a2L = G; LAS float* m2L = G + 64; LAS float* winL = G + 128; LAS float* clL = G + 192; LAS float* wkL = G + 256;
#pragma unroll
            for (int i = 0; i < 4; ++i) { const int idx = tid + 512 * i, row = idx >> 5, c16 = idx & 31;
                *(LAS v4u*)(L + O_Q + row * QP + c16 * 16) = pq[i]; *(LAS v4u*)(L + O_K + row * QP + c16 * 16) = pk[i]; }
            { const int s = tid >> 3, cc = tid & 7; const float wks = wkL[s];
              *(LAS v4u*)(L + O_V + s * VP + cc * 16) = pv;
              pg8::u32x4 o; o.x = pg8::cvt_pk_bf16(bflo(pv.x) * wks, bfhi(pv.x) * wks); o.y = pg8::cvt_pk_bf16(bflo(pv.y) * wks, bfhi(pv.y) * wks);
              o.z = pg8::cvt_pk_bf16(bflo(pv.z) * wks, bfhi(pv.z) * wks); o.w = pg8::cvt_pk_bf16(bflo(pv.w) * wks, bfhi(pv.w) * wks);
              *(LAS pg8::u32x4*)(L + O_WV + s * VP + cc * 16) = o; }
            ML_LDS_BARRIER();
            if (chunk + 1 < 128) { const size_t m1 = m0 + 64;
#pragma unroll
                for (int i = 0; i < 4; ++i) { const int idx = tid + 512 * i, row = idx >> 5, c16 = idx & 31;
                    pq[i] = *(const GAS v4u*)(qg + (m1 + row) * 2048 + c16 * 8); pk[i] = *(const GAS v4u*)(kg + (m1 + row) * 2048 + c16 * 8); }
                pv = *(const GAS v4u*)(vg + (m1 + (tid >> 3)) * 4096 + (tid & 7) * 8); }
            f32x4v Hq[NCT];
#pragma unroll
            for (int y = 0; y < NCT; ++y) Hq[y] = (f32x4v){0.f, 0.f, 0.f, 0.f};
            if (w < 4) {
                const int ti = w;
                bf16x8v qf[8];
#pragma unroll
                for (int ke = 0; ke < 8; ++ke) qf[ke] = *(const LAS bf16x8v*)(L + O_Q + (16 * ti + fr) * QP + 16 * fq + 64 * ke);
                f32x4v St[4];
#pragma unroll
                for (int sj = 0; sj < 4; ++sj) {
                    St[sj] = (f32x4v){0.f, 0.f, 0.f, 0.f};
                    if (sj <= ti) {
                    bf16x8v kf[8];
#pragma unroll
                    for (int ke = 0; ke < 8; ++ke) kf[ke] = *(const LAS bf16x8v*)(L + O_K + (16 * sj + fr) * QP + 16 * fq + 64 * ke);
                    f32x4v acc0 = (f32x4v){0.f, 0.f, 0.f, 0.f}, acc1 = (f32x4v){0.f, 0.f, 0.f, 0.f};
#pragma unroll
                    for (int ke = 0; ke < 8; ke += 2) { acc0 = __builtin_amdgcn_mfma_f32_16x16x32_bf16(kf[ke], qf[ke], acc0, 0, 0, 0); acc1 = __builtin_amdgcn_mfma_f32_16x16x32_bf16(kf[ke + 1], qf[ke + 1], acc1, 0, 0, 0); }
                    St[sj] = acc0 + acc1; }
                }
                const float m2t = m2L[16 * ti + fr]; float dsum = 0.f;
#pragma unroll
                for (int sj = 0; sj < 4; ++sj) {
                    const f32x4v a4 = *(const LAS f32x4v*)(a2L + 16 * sj + 4 * fq);
#pragma unroll
                    for (int i = 0; i < 4; ++i) { const bool ok = (sj < ti) || (sj == ti && 4 * fq + i <= fr);
                        const float v = St[sj][i] * __builtin_amdgcn_exp2f(fminf(a4[i] - m2t, 0.f)); St[sj][i] = ok ? v : 0.f; dsum += St[sj][i]; }
                }
                dsum += __shfl_xor(dsum, 16); dsum += __shfl_xor(dsum, 32);
                if (fq == 0) diL[16 * ti + fr] = dsum;
                f32x4v Hi[NVT];
#pragma unroll
                for (int vt = 0; vt < NVT; ++vt) Hi[vt] = (f32x4v){0.f, 0.f, 0.f, 0.f};
#pragma unroll
                for (int p = 0; p < 2; ++p) if (2 * p <= ti) {
                    const bf16x8v af = pack8v(St[2 * p][0], St[2 * p][1], St[2 * p][2], St[2 * p][3], St[2 * p + 1][0], St[2 * p + 1][1], St[2 * p + 1][2], St[2 * p + 1][3]);
#pragma unroll
                    for (int vt = 0; vt < NVT; ++vt) { LAS unsigned char* vb = L + O_V + (32 * p + 4 * fq + trq) * VP + 32 * vt + 8 * trp;
                        Hi[vt] = __builtin_amdgcn_mfma_f32_16x16x32_bf16(af, tr_pair(vb, vb + 16 * VP), Hi[vt], 0, 0, 0); }
                }
#pragma unroll
                for (int vt = 0; vt < NVT; ++vt)
#pragma unroll
                    for (int i = 0; i < 4; ++i) hiL[(16 * ti + 4 * fq + i) * HIP + 16 * vt + fr] = Hi[vt][i];
            } else {
                const int ti = w - 4;
                bf16x8v qf[8];
#pragma unroll
                for (int ke = 0; ke < 8; ++ke) qf[ke] = *(const LAS bf16x8v*)(L + O_Q + (16 * ti + fr) * QP + 16 * fq + 64 * ke);
#pragma unroll
                for (int y = 0; y < NCT; ++y) {
                    bf16x8v cf[8];
#pragma unroll
                    for (int ke = 0; ke < 8; ++ke) cf[ke] = *(const LAS bf16x8v*)(L + O_CT + (16 * y + fr) * QP + 16 * fq + 64 * ke);
                    f32x4v ha = (f32x4v){0.f, 0.f, 0.f, 0.f}, hb = ha;
#pragma unroll
                    for (int ke = 0; ke < 8; ke += 2) { ha = __builtin_amdgcn_mfma_f32_16x16x32_bf16(qf[ke], cf[ke], ha, 0, 0, 0); hb = __builtin_amdgcn_mfma_f32_16x16x32_bf16(qf[ke + 1], cf[ke + 1], hb, 0, 0, 0); }
                    Hq[y] = ha + hb;
                }
            }
            ML_LDS_BARRIER();
            if (w >= 4) {
                const int ti = w - 4, t0 = 16 * ti + 4 * fq;
                const f32x4v wi = *(const LAS f32x4v*)(winL + t0), di = *(const LAS f32x4v*)(diL + t0), cl = *(const LAS f32x4v*)(clL + t0);
                f32x4v qn4;
#pragma unroll
                for (int i = 0; i < 4; ++i) qn4[i] = __shfl(Hq[NVT][i], lane & 48);
                float hv[4][NVT];
#pragma unroll
                for (int i = 0; i < 4; ++i) { const float den = wi[i] * qn4[i] + di[i], rd = __builtin_amdgcn_rcpf(fmaxf(fabsf(den), cl[i]));
#pragma unroll
                    for (int vt = 0; vt < NVT; ++vt) hv[i][vt] = (wi[i] * Hq[vt][i] + hiL[(t0 + i) * HIP + 16 * vt + fr]) * rd; }
                LAS unsigned char* ot = L + O_HI + (16 * ti) * HIP * 4;
                asm volatile("" ::: "memory");
#pragma unroll
                for (int i = 0; i < 4; ++i) {
#pragma unroll
                    for (int vt = 0; vt < NVT; ++vt) *(LAS bf16*)(ot + (4 * fq + i) * VP + (16 * vt + fr) * 2) = (bf16)(pg8::cvt_pk_bf16(hv[i][vt], 0.f) & 0xffffu); }
                LDS_WAIT(); asm volatile("" ::: "memory");
#pragma unroll
                for (int pz = 0; pz < VW / 32; ++pz) { const int pc = lane + 64 * pz, orow = pc / (VW / 8), oc = (pc % (VW / 8)) * 8;
                    *(GAS v4u*)(hg + (m0 + 16 * ti + orow) * 4096 + oc) = *(const LAS v4u*)(ot + orow * VP + oc * 2); }
            }
            { const float decay = G[320];
              bf16x8v kf[2][2], wf[2][NCT];
#pragma unroll
              for (int ks = 0; ks < 2; ++ks) {
#pragma unroll
                  for (int x = 0; x < 2; ++x) if (x < ne) { LAS unsigned char* kb_ = L + O_K + (32 * ks + 8 * fq + trq) * QP + (16 * (e0 + x)) * 2 + 8 * trp; kf[ks][x] = tr_pair(kb_, kb_ + 4 * QP); }
#pragma unroll
                  for (int y = 0; y < NVT; ++y) { LAS unsigned char* wb_ = L + O_WV + (32 * ks + 8 * fq + trq) * VP + 32 * y + 8 * trp; wf[ks][y] = tr_pair(wb_, wb_ + 4 * VP); }
                  const f32x4v k0 = *(const LAS f32x4v*)(wkL + 32 * ks + 8 * fq), k1 = *(const LAS f32x4v*)(wkL + 32 * ks + 8 * fq + 4);
                  const bf16x8v wkf = pack8v(k0[0], k0[1], k0[2], k0[3], k1[0], k1[1], k1[2], k1[3]);
                  wf[ks][NVT] = (fr == 0) ? wkf : (bf16x8v){0, 0, 0, 0, 0, 0, 0, 0};
              }
#pragma unroll
              for (int x = 0; x < 2; ++x) if (x < ne) {
#pragma unroll
                  for (int y = 0; y < NCT; ++y) { f32x4v c = Cm[x][y] * decay;
                      c = __builtin_amdgcn_mfma_f32_16x16x32_bf16(kf[0][x], wf[0][y], c, 0, 0, 0); c = __builtin_amdgcn_mfma_f32_16x16x32_bf16(kf[1][x], wf[1][y], c, 0, 0, 0); Cm[x][y] = c;
                      v2u o; o.x = pg8::cvt_pk_bf16(c[0], c[1]); o.y = pg8::cvt_pk_bf16(c[2], c[3]);
                      *(LAS v2u*)(L + O_CT + (16 * y + fr) * QP + (16 * (e0 + x) + 4 * fq) * 2) = o; } }
            }
            if (w == 0 && chunk + 1 < 128) {
                mlstm_gates(gi_pre, gf_pre, bi, bfv, m_prev, lane, (LAS float*)(L + O_G + ((chunk + 1) & 1) * GSZ));
                if (chunk + 2 < 128) { gi_pre = ig[(m0 + 128 + lane) * 16]; gf_pre = ig[(m0 + 128 + lane) * 16 + 8]; } }
            ML_LDS_BARRIER();
        }
    }
}
struct P3Args { const bf16* AO; const float* LSE; const bf16* HRAW; const bf16* MO; const float* g_mls; unsigned char *ATTQ, *MLSQ; float *SAA, *SAM; };
__device__ __forceinline__ unsigned q8(float x, float qs) { return (unsigned)(int)__builtin_rintf(fminf(fmaxf(x * qs, -127.f), 127.f)) & 255u; }
__device__ __forceinline__ v2u q8x8(const float (&v)[8], float qs) {
    v2u o; o.x = q8(v[0], qs) | (q8(v[1], qs) << 8) | (q8(v[2], qs) << 16) | (q8(v[3], qs) << 24); o.y = q8(v[4], qs) | (q8(v[5], qs) << 8) | (q8(v[6], qs) << 16) | (q8(v[7], qs) << 24); return o;
}
__device__ __forceinline__ void p3_mix(const Ctx& F, const P3Args& A) {
    const int gw = F.bx * NWAVES + F.wave, NGW = F.G * NWAVES, lane = F.lane;
    for (int m = gw; m < M; m += NGW) {
        float r[2][8]; float rmax = 0.f;
#pragma unroll
        for (int cc = 0; cc < 2; ++cc) { const int c8 = lane + 64 * cc, h = c8 >> 4;
            const float l0 = A.LSE[((size_t)0 * M + m) * 8 + h], l1 = A.LSE[((size_t)1 * M + m) * 8 + h], l2 = A.LSE[((size_t)2 * M + m) * 8 + h];
            const float mx = fmaxf(l0, fmaxf(l1, l2)); float w0 = __expf(l0 - mx), w1 = __expf(l1 - mx), w2 = __expf(l2 - mx); const float inv = 1.0f / (w0 + w1 + w2); w0 *= inv; w1 *= inv; w2 *= inv;
            const v4u a = *(const GAS v4u*)(A.AO + (size_t)m * 1024 + c8 * 8), b = *(const GAS v4u*)(A.AO + pg8::ATT_G + (size_t)m * 1024 + c8 * 8), c = *(const GAS v4u*)(A.AO + 2 * pg8::ATT_G + (size_t)m * 1024 + c8 * 8);
            r[cc][0] = w0 * bflo(a.x) + w1 * bflo(b.x) + w2 * bflo(c.x); r[cc][1] = w0 * bfhi(a.x) + w1 * bfhi(b.x) + w2 * bfhi(c.x);
            r[cc][2] = w0 * bflo(a.y) + w1 * bflo(b.y) + w2 * bflo(c.y); r[cc][3] = w0 * bfhi(a.y) + w1 * bfhi(b.y) + w2 * bfhi(c.y);
            r[cc][4] = w0 * bflo(a.z) + w1 * bflo(b.z) + w2 * bflo(c.z); r[cc][5] = w0 * bfhi(a.z) + w1 * bfhi(b.z) + w2 * bfhi(c.z);
            r[cc][6] = w0 * bflo(a.w) + w1 * bflo(b.w) + w2 * bflo(c.w); r[cc][7] = w0 * bfhi(a.w) + w1 * bfhi(b.w) + w2 * bfhi(c.w);
#pragma unroll
            for (int q = 0; q < 8; ++q) rmax = fmaxf(rmax, fabsf(r[cc][q])); }
        rmax = wave_max(rmax); const float qs = rmax > 0.f ? 127.0f / rmax : 0.f;
        if (lane == 0) A.SAA[m] = rmax * (1.0f / 127.0f);
#pragma unroll
        for (int cc = 0; cc < 2; ++cc) *(GAS v2u*)(A.ATTQ + (size_t)m * 1024 + (lane + 64 * cc) * 8) = q8x8(r[cc], qs);
    }
    for (int m = gw; m < M; m += NGW) {
        v4u hw[8]; v2u ow[8];
#pragma unroll
        for (int h = 0; h < 8; ++h) { const size_t off = (size_t)m * 4096 + (size_t)h * 512 + lane * 8; hw[h] = *(const GAS v4u*)(A.HRAW + off); ow[h] = *(const GAS v2u*)((const GAS unsigned char*)A.MO + off); }
        float r[8][8]; float rmax = 0.f;
#pragma unroll
        for (int h = 0; h < 8; ++h) {
            const float hv[8] = {bflo(hw[h].x), bfhi(hw[h].x), bflo(hw[h].y), bfhi(hw[h].y), bflo(hw[h].z), bfhi(hw[h].z), bflo(hw[h].w), bfhi(hw[h].w)};
            const float ov[8] = {(float)(ow[h].x & 255u), (float)((ow[h].x >> 8) & 255u), (float)((ow[h].x >> 16) & 255u), (float)(ow[h].x >> 24), (float)(ow[h].y & 255u), (float)((ow[h].y >> 8) & 255u), (float)((ow[h].y >> 16) & 255u), (float)(ow[h].y >> 24)};
            float s = 0.f;
#pragma unroll
            for (int q = 0; q < 8; ++q) s += hv[q] * hv[q];
            const float rstd = 1.f / sqrtf(wave_sum(s) * (1.f / 512.f) + RMS_EPS);
            const f32x4 g0 = *(const GAS f32x4*)(A.g_mls + h * 512 + lane * 8), g1 = *(const GAS f32x4*)(A.g_mls + h * 512 + lane * 8 + 4);
            const float gg[8] = {g0.x, g0.y, g0.z, g0.w, g1.x, g1.y, g1.z, g1.w};
#pragma unroll
            for (int q = 0; q < 8; ++q) { r[h][q] = hv[q] * rstd * gg[q] * (ov[q] * (1.0f / 255.0f)); rmax = fmaxf(rmax, fabsf(r[h][q])); }
        }
        rmax = wave_max(rmax); const float qs = rmax > 0.f ? 127.0f / rmax : 0.f;
        if (lane == 0) A.SAM[m] = rmax * (1.0f / 127.0f);
#pragma unroll
        for (int h = 0; h < 8; ++h) *(GAS v2u*)(A.MLSQ + (size_t)m * 4096 + (size_t)h * 512 + lane * 8) = q8x8(r[h], qs);
    }
}
__device__ __forceinline__ void p45_quant_rows(const Ctx& F, const bf16* X, unsigned char* XQ, float* SAo) {
    const int gw = F.bx * NWAVES + F.wave, NGW = F.G * NWAVES, lane = F.lane;
    for (int m = gw; m < M; m += NGW) {
        v4u w[8]; float rmax = 0.f;
#pragma unroll
        for (int j = 0; j < 8; ++j) w[j] = *(const GAS v4u*)(X + (size_t)m * 4096 + (lane + 64 * j) * 8);
#pragma unroll
        for (int j = 0; j < 8; ++j) rmax = fmaxf(rmax, fmaxf(fmaxf(fmaxf(fabsf(bflo(w[j].x)), fabsf(bfhi(w[j].x))), fmaxf(fabsf(bflo(w[j].y)), fabsf(bfhi(w[j].y)))), fmaxf(fmaxf(fabsf(bflo(w[j].z)), fabsf(bfhi(w[j].z))), fmaxf(fabsf(bflo(w[j].w)), fabsf(bfhi(w[j].w))))));
        rmax = wave_max(rmax); const float qs = rmax > 0.f ? 127.0f / rmax : 0.f;
        if (lane == 0) SAo[m] = rmax * (1.0f / 127.0f);
#pragma unroll
        for (int j = 0; j < 8; ++j) { const float v[8] = {bflo(w[j].x), bfhi(w[j].x), bflo(w[j].y), bfhi(w[j].y), bflo(w[j].z), bfhi(w[j].z), bflo(w[j].w), bfhi(w[j].w)};
            *(GAS v2u*)(XQ + (size_t)m * 4096 + (lane + 64 * j) * 8) = q8x8(v, qs); }
    }
}
__device__ __forceinline__ void p6_rmsnorm(const Ctx& F, const float* h, const float* g, bf16* HN) {
    const int gw = F.bx * NWAVES + F.wave, NGW = F.G * NWAVES;
    for (int m = gw; m < M; m += NGW) rms_row_to_bf16(h + (size_t)m * D, g, HN + (size_t)m * D, F.lane);
}
__device__ __forceinline__ void p9_final(const Ctx& F, const bf16* H2, const float* SS, const float* g, float* out) {
    const size_t gt = (size_t)F.bx * (NWAVES * 64) + F.tid, NT = (size_t)F.G * NWAVES * 64;
    for (size_t i = gt; i < (size_t)M * D / 8; i += NT) {
        const size_t m = i >> 9; const int c8 = (int)(i & 511) * 8;
        const v4u hw = *(const GAS v4u*)(H2 + i * 8);
        const float rstd = 1.f / sqrtf(SS[m] * (1.f / D) + RMS_EPS);
        const f32x4 g0 = *(const GAS f32x4*)(g + c8), g1 = *(const GAS f32x4*)(g + c8 + 4);
        f32x4 o0, o1;
        o0.x = bflo(hw.x) * rstd * g0.x; o0.y = bfhi(hw.x) * rstd * g0.y; o0.z = bflo(hw.y) * rstd * g0.z; o0.w = bfhi(hw.y) * rstd * g0.w;
        o1.x = bflo(hw.z) * rstd * g1.x; o1.y = bfhi(hw.z) * rstd * g1.y; o1.z = bflo(hw.w) * rstd * g1.z; o1.w = bfhi(hw.w) * rstd * g1.w;
        *(GAS f32x4*)(out + i * 8) = o0; *(GAS f32x4*)(out + i * 8 + 4) = o1;
    }
}

struct Args { const float* in[15]; float* out; unsigned char* ws; int ph_lo, ph_hi, li, pad; };
__global__ void __launch_bounds__(NWAVES * 64, 2) hybrid_fwd(Args args) {
    extern __shared__ __attribute__((aligned(16))) unsigned char lds[];
    Ctx F;
    F.lds = (LAS unsigned char*)lds;
    volatile LAS unsigned* MISC = (volatile LAS unsigned*)(F.lds + MISC_OFF);
    F.tid = threadIdx.x; F.lane = F.tid & 63; F.wave = __builtin_amdgcn_readfirstlane(F.tid >> 6);
    F.G = gridDim.x; F.bx = blockIdx.x;
    unsigned char* ws = args.ws;
    gu32* ctl = (gu32*)(ws + WS_CTL);
    const float* x = args.in[0]; const float* g_mix = args.in[1]; const float* w_in = args.in[2]; const float* b_ig = args.in[3]; const float* b_fg = args.in[4];
    const float* g_mls = args.in[5]; const float* w_attn = args.in[6]; const float* w_mlstm = args.in[7]; const float* w_gate = args.in[8]; const float* b_gate = args.in[9];
    const float* w_out = args.in[10]; const float* g_mlp = args.in[11]; const float* w_up = args.in[12]; const float* w_down = args.in[13]; const float* g_fin = args.in[14];
    float* out = args.out;
    bf16* WCAT = (bf16*)(ws + WS_WCAT); bf16* WATT = (bf16*)(ws + WS_WATT); bf16* WMLS = (bf16*)(ws + WS_WMLS); bf16* WOUT = (bf16*)(ws + WS_WOUT);
    bf16* WUP = (bf16*)(ws + WS_WUP); bf16* WDOWN = (bf16*)(ws + WS_WDOWN); bf16* XN = (bf16*)(ws + WS_XN);
    unsigned char* XNQ = ws + WS_XN8; unsigned char* WQ = ws + WS_WCAT;
    unsigned char* ATTQ = ws + WS_ATT; unsigned char* MLSQ = ws + WS_MLS; unsigned char* MERGEDQ = ws + WS_MLS;
    float* SCL = (float*)(ws + WS_SCL); float* SAA = SCL + SCL_SAA; float* SAM = SCL + SCL_SAM; float* SAG = SCL + SCL_SAG; float* SAH = SCL + SCL_SAH; float* XR = SCL + SCL_XR;
    float* SA = SCL + SCL_SA; unsigned* CMAX = (unsigned*)(ws + WS_CTL) + CW_CMAX; float* SB = SCL + SCL_SB;
    unsigned char* H1Q = ws + WS_MERGED;
    bf16* QKV = (bf16*)(ws + WS_QKV); bf16* MQ = (bf16*)(ws + WS_MQ); bf16* MK = (bf16*)(ws + WS_MK); bf16* MV = (bf16*)(ws + WS_MV); bf16* MO = (bf16*)(ws + WS_MO);
    float* IFG = (float*)(ws + WS_IFG); float* LSE = (float*)(ws + WS_LSE); bf16* GATES = (bf16*)out;
    bf16* AO = (bf16*)(ws + WS_AO); bf16* HRAW = (bf16*)(ws + WS_HRAW); bf16* ATT = (bf16*)(ws + WS_ATT); bf16* MLS = (bf16*)(ws + WS_MLS);
    bf16* T1 = (bf16*)(ws + WS_T1); float* SS1 = (float*)(ws + WS_CTL) + CW_SS1; float* SS2 = SS1 + M; bf16* MERGED = (bf16*)(ws + WS_MERGED); bf16* HG = (bf16*)(ws + WS_HG); bf16* U = (bf16*)(ws + WS_U);

    for (int u = F.tid; u < (LDS_BYTES - LDSCTL_OFF) / 4; u += NWAVES * 64) ((LAS unsigned*)(F.lds + LDSCTL_OFF))[u] = 0u;
    __syncthreads();
    XcdBarrier bar; bar.bar = (unsigned*)(ctl + CW_BAR); bar.x = 0; bar.st = nullptr;
    if (N_LAUNCHES != PER_PHASE) bar = xcd_barrier_post((unsigned*)(ctl + CW_BAR), MISC + 8);
#define GRID_BAR(seam) do { if (N_LAUNCHES == PER_PHASE) { if (F.tid == 0) __hip_atomic_store(ctl + CW_TMO, 0xBADBA0u | (unsigned)(seam), RLX_AGENT); } else { xcd_barrier(bar); } } while (0)
    const int lo = args.ph_lo, hi = args.ph_hi;
#if defined(MK_LAST_PHASE)
    if (lo > MK_LAST_PHASE) return;
#endif
#define IN(k) (lo <= (k) && (k) < hi)
#define BOTH(k) (IN(k) && IN((k) + 1))

    if (IN(0)) { const P0Args A{x, g_mix, w_in, w_attn, w_mlstm, w_gate, w_out, w_up, g_mlp, WCAT, WATT, WMLS, WOUT, XN, SS1, XNQ, WQ, SA, CMAX, SB, XR};
        p0_pass_a(F, A); GRID_BAR(0); p0_prologue(F, A);
#if MK_DUP == 0
        GRID_BAR(0); p0_prologue(F, A);
#endif
        if (BOTH(0)) GRID_BAR(0); }
    if (IN(1)) {
        pg8::Gemm g{(const pg8::bf16_t*)XNQ, (const pg8::bf16_t*)WQ, M, NCAT - 256 - 4096, D / 2, SA, SB}; pg8::StaticOrder S; S.init(M, NCAT - 256 - 4096, F.G, F.bx, 8, 36, 16);
        pg8::EpiInProj E{QKV, ws, GATES, b_gate, 0, 1.0f};
        {
          pg8::Gemm gb{XN, WCAT + (size_t)14848 * D, M, 4096, D}; pg8::StaticOrder Sb; Sb.init(M, 4096, F.G, F.bx); pg8::EpiInProj Eb{QKV, ws, GATES, b_gate, 36, 1.0f};
          pg8::gemm_phase<pg8::EpiInProj, pg8::StaticOrder, PG8_ALIGN, PG8_SP2>(F.lds + RING_OFF, gb, Sb, Eb); }
        static_assert(pg8::EpiInProj::MQ_OFF == WS_MQ && pg8::EpiInProj::MK_OFF == WS_MK && pg8::EpiInProj::MV_OFF == WS_MV && pg8::EpiInProj::MO_OFF == WS_MO, "epilogue offsets vs ws map");
        pg8::gemm_phase<pg8::EpiInProj, pg8::StaticOrder, PG8_ALIGN, PG8_SP2, 2>(F.lds + RING_OFF, g, S, E);
        { Ctx F2 = F; asm volatile("" : "+v"(F2.lane), "+v"(F2.tid));
          p1_if_gates(F2, XN, WCAT + (size_t)(NCAT - 256) * D, IFG); }
        if (BOTH(1)) GRID_BAR(1);
    }
    if (IN(2)) {
        if (F.G >= 2) {
            const int half = F.G >> 1, odd_n = F.G - half;
            if ((F.bx & 1) == 0 && (F.bx >> 1) < half) { mlstm_fast(F, MQ, MK, MV, IFG, b_ig, b_fg, HRAW, F.bx >> 1, half);
#if MK_DUP == 21
                __syncthreads(); mlstm_fast(F, MQ, MK, MV, IFG, b_ig, b_fg, HRAW, F.bx >> 1, half);
#endif
            } else { attn_fast(F, QKV, AO, LSE, w_up, w_down, WUP, WDOWN, g_mlp, CMAX + 41984, SB + 41984, (F.bx & 1) ? (F.bx >> 1) : (odd_n - 1), odd_n);
#if MK_DUP == 20
                attn_fast(F, QKV, AO, LSE, w_up, w_down, WUP, WDOWN, g_mlp, CMAX + 41984, SB + 41984, (F.bx & 1) ? (F.bx >> 1) : (odd_n - 1), odd_n);
#endif
            }
        } else { attn_fast(F, QKV, AO, LSE, w_up, w_down, WUP, WDOWN, g_mlp, CMAX + 41984, SB + 41984, 0, 1); __syncthreads(); mlstm_fast(F, MQ, MK, MV, IFG, b_ig, b_fg, HRAW, 0, 1); }
        if (BOTH(2)) GRID_BAR(2);
    }
    if (IN(3)) { const P3Args A{AO, LSE, HRAW, MO, g_mls, ATTQ, MLSQ, SAA, SAM}; p3_mix(F, A);
#if MK_DUP == 3
        GRID_BAR(3); p3_mix(F, A);
#endif
        if (BOTH(3)) GRID_BAR(3); }
    if (IN(4)) {
        const pg8::Gemm ga{(const pg8::bf16_t*)ATTQ, (const pg8::bf16_t*)WATT, M, D, 512, SAA, SB + 29696};
        const pg8::Gemm gm{(const pg8::bf16_t*)MLSQ, (const pg8::bf16_t*)WMLS, M, D, 2048, SAM, SB + 33792};
        pg8::StaticOrder S; S.init(M, D, F.G, F.bx);
        if ((F.bx & 1) == 0) {
        { pg8::EpiBranchA E{T1}; pg8::gemm_phase<pg8::EpiBranchA, pg8::StaticOrder, PG8_ALIGN, PG8_SP2, 2>(F.lds + RING_OFF, ga, S, E); }
        VM_WAIT();
        { pg8::EpiBranchM E{T1, GATES, MERGED}; pg8::gemm_phase<pg8::EpiBranchM, pg8::StaticOrder, PG8_ALIGN, PG8_SP2, 2>(F.lds + RING_OFF, gm, S, E); }
        } else {
        { pg8::EpiBranchM1 E{T1, GATES}; pg8::gemm_phase<pg8::EpiBranchM1, pg8::StaticOrder, PG8_ALIGN, PG8_SP2, 2>(F.lds + RING_OFF, gm, S, E); }
        VM_WAIT();
        { pg8::EpiBranchA2 E{T1, GATES, MERGED}; pg8::gemm_phase<pg8::EpiBranchA2, pg8::StaticOrder, PG8_ALIGN, PG8_SP2, 2>(F.lds + RING_OFF, ga, S, E); }
        }
        GRID_BAR(4);
        p45_quant_rows(F, MERGED, MERGEDQ, SAG);
        if (BOTH(4)) GRID_BAR(4);
    }
    if (IN(5)) {
        pg8::Gemm g{(const pg8::bf16_t*)MERGEDQ, (const pg8::bf16_t*)WOUT, M, D, 2048, SAG, SB + 37888}; pg8::StaticOrder S; S.init(M, D, F.G, F.bx); pg8::EpiOutProj E{XN, XR, g_mix, HG, SS1};
        pg8::gemm_phase<pg8::EpiOutProj, pg8::StaticOrder, PG8_ALIGN, PG8_SP2, 2>(F.lds + RING_OFF, g, S, E);
        GRID_BAR(5);
        p45_quant_rows(F, HG, H1Q, SAH);
        if (BOTH(5)) GRID_BAR(5);
    }
    if (IN(7)) {
        pg8::EpiUp E{U, SS1};
        { pg8::Gemm g{(const pg8::bf16_t*)H1Q, (const pg8::bf16_t*)WUP, M, 256 * NUP8, 2048, SAH, SB + 41984}; pg8::StaticOrder S; S.init(M, 256 * NUP8, F.G, F.bx);
          pg8::gemm_phase<pg8::EpiUp, pg8::StaticOrder, PG8_ALIGN, PG8_SP2, 2>(F.lds + RING_OFF, g, S, E); }
        if (NUP8 < 64) { pg8::Gemm g{HG, WUP, M, 256 * (64 - NUP8), D}; pg8::StaticOrder S; S.init(M, 256 * (64 - NUP8), F.G, F.bx, 8, 0, NUP8);
          pg8::gemm_phase<pg8::EpiUp, pg8::StaticOrder, PG8_ALIGN, PG8_SP2>(F.lds + RING_OFF, g, S, E); }
        if (BOTH(7)) GRID_BAR(7);
    }
    if (IN(8)) {
        pg8::Gemm g{U, WDOWN, M, D, FF}; pg8::StaticOrder S; S.init(M, D, F.G, F.bx, 4); pg8::EpiDown E{HG, SS2};
        pg8::gemm_phase<pg8::EpiDown, pg8::StaticOrder, PG8_ALIGN, PG8_SP2>(F.lds + RING_OFF, g, S, E);
        if (BOTH(8)) GRID_BAR(8);
    }
    if (IN(9)) p9_final(F, HG, SS2, g_fin, out);
#undef IN
#undef BOTH
}

extern "C" void kernel_launch(void* const* d_in, const int* in_sizes, int n_in, void* d_out, int out_size, void* d_ws, size_t ws_size, hipStream_t stream) {
    static int grid = 0;
    if (grid == 0) {
        if (n_in != 15 || in_sizes[0] != M * D || out_size != M * D || ws_size < WS_END) { fprintf(stderr, "kernel_launch: unexpected shapes (n_in %d, in0 %d, out %d, ws %zu < %zu); nothing launched\n", n_in, n_in > 0 ? in_sizes[0] : -1, out_size, ws_size, (size_t)WS_END); grid = -1; return; }
        int dev = 0, cus = 0, per_cu = 0;
        if (hipGetDevice(&dev) != hipSuccess || hipDeviceGetAttribute(&cus, hipDeviceAttributeMultiprocessorCount, dev) != hipSuccess) { grid = -1; return; }
        if (hipFuncSetAttribute((const void*)hybrid_fwd, hipFuncAttributeMaxDynamicSharedMemorySize, LDS_BYTES) != hipSuccess) { fprintf(stderr, "kernel_launch: hipFuncSetAttribute failed\n"); grid = -1; return; }
        if (hipOccupancyMaxActiveBlocksPerMultiprocessor(&per_cu, (const void*)hybrid_fwd, NWAVES * 64, LDS_BYTES) != hipSuccess || per_cu < 1)
            fprintf(stderr, "kernel_launch: note: occupancy query reports %d workgroups per CU\n", per_cu);
        (void)hipGetLastError();
        grid = cus;
    }
    if (grid < 0) return;
    if (N_LAUNCHES != PER_PHASE) { if (hipMemsetAsync((char*)d_ws + WS_CTL, 0, CTL_ZERO_BYTES, stream) != hipSuccess) return; }
    Args a{};
    for (int i = 0; i < 15; ++i) a.in[i] = (const float*)d_in[i];
    a.out = (float*)d_out; a.ws = (unsigned char*)d_ws;
    for (int li = 0; li < N_LAUNCHES; ++li) {
        a.ph_lo = (N_LAUNCHES == PER_PHASE) ? li : 0; a.ph_hi = (N_LAUNCHES == PER_PHASE) ? li + 1 : PER_PHASE; a.li = li;
        hipLaunchKernelGGL(hybrid_fwd, dim3(grid), dim3(NWAVES * 64), LDS_BYTES, stream, a);
        const hipError_t le = hipPeekAtLastError();
        if (le != hipSuccess) { fprintf(stderr, "kernel_launch: launch %d failed: %s\n", li, hipGetErrorName(le)); break; }
    }
}
```
